# Optimizing an MI355X kernel written in HIP

```python
import math
import jax, jax.numpy as jnp
from jax import lax
import numpy as np

D_MODEL = 1024
BATCH = 16
SEQ = 2048
DEPTH = 4

N_MIXERS = 2
N_A_LAYERS = (DEPTH + N_MIXERS - 1) // N_MIXERS
N_B_LAYERS = DEPTH // N_MIXERS
A_HEADS = D_MODEL // 128
A_DHEAD = D_MODEL // (2 * A_HEADS)
A_VDIM = 2 * A_DHEAD
Q_BLOCK = 128
R_HEADS = max(4, D_MODEL // 256)
R_DK = D_MODEL // R_HEADS
R_DV = 2 * R_DK
CHUNK = 128
D_FF = 4 * D_MODEL
PLE_DIM = 256
EPS = 1e-6

kernel_name = "hybrid_diffattn_retnet_sqrelu_ple"


def rms_norm(x, g):
    xf = x.astype(jnp.float32)
    y = xf * lax.rsqrt(jnp.mean(xf * xf, axis=-1, keepdims=True) + EPS)
    return (y * g.astype(jnp.float32)).astype(x.dtype)


def alibi_slopes(n):
    return jnp.array([2.0 ** (-8.0 * (h + 1) / n) for h in range(n)], dtype=jnp.float32)


def diff_attention(xn, w_qkv, w_o, g_q, g_k, lam_q1, lam_k1, lam_q2, lam_k2, g_sub, lambda_init):
    B, S, _ = xn.shape
    qkv = xn @ w_qkv
    q = qkv[..., :D_MODEL].reshape(B, S, A_HEADS, 2, A_DHEAD)
    k = qkv[..., D_MODEL:2 * D_MODEL].reshape(B, S, A_HEADS, 2, A_DHEAD)
    v = qkv[..., 2 * D_MODEL:].reshape(B, S, A_HEADS, A_VDIM)
    q = rms_norm(q, g_q) * (A_DHEAD ** -0.5)
    k = rms_norm(k, g_k)
    lam = (jnp.exp(jnp.sum(lam_q1.astype(jnp.float32) * lam_k1.astype(jnp.float32)))
           - jnp.exp(jnp.sum(lam_q2.astype(jnp.float32) * lam_k2.astype(jnp.float32)))
           + lambda_init)
    slopes = alibi_slopes(A_HEADS)
    nb = S // Q_BLOCK
    q_blocks = q.reshape(B, nb, Q_BLOCK, A_HEADS, 2, A_DHEAD).transpose(1, 0, 2, 3, 4, 5)
    key_pos = jnp.arange(S)

    def one_block(args):
        qb, bi = args
        q_pos = bi * Q_BLOCK + jnp.arange(Q_BLOCK)
        s = jnp.einsum('bqhcd,bkhcd->bhcqk', qb, k).astype(jnp.float32)
        dist = q_pos[:, None] - key_pos[None, :]
        bias = -slopes[:, None, None] * dist.astype(jnp.float32)
        s = s + bias[None, :, None]
        s = jnp.where(dist[None, None, None] >= 0, s, -jnp.inf)
        a = jax.nn.softmax(s, axis=-1)
        attn = a[:, :, 0] - lam * a[:, :, 1]
        return jnp.einsum('bhqk,bkhe->bqhe', attn.astype(v.dtype), v)

    o = lax.map(one_block, (q_blocks, jnp.arange(nb)))
    o = o.transpose(1, 0, 2, 3, 4).reshape(B, S, A_HEADS, A_VDIM)
    o = rms_norm(o, g_sub) * (1.0 - lambda_init)
    return o.reshape(B, S, A_HEADS * A_VDIM) @ w_o


def retention(xn, w_in, w_out, g_gn):
    B, S, _ = xn.shape
    dt = xn.dtype
    proj = xn @ w_in
    qw, kw, vw = R_HEADS * R_DK, R_HEADS * R_DK, R_HEADS * R_DV
    q = proj[..., :qw]
    k = proj[..., qw:qw + kw] * (R_DK ** -0.5)
    v = proj[..., qw + kw:qw + kw + vw]
    gate = proj[..., qw + kw + vw:]
    N = S // CHUNK
    qc = q.reshape(B, N, CHUNK, R_HEADS, R_DK)
    kc = k.reshape(B, N, CHUNK, R_HEADS, R_DK)
    vc = v.reshape(B, N, CHUNK, R_HEADS, R_DV)

    gamma = 1.0 - 2.0 ** (-5.0 - jnp.arange(R_HEADS, dtype=jnp.float32))
    log_g = jnp.log(gamma)
    pos = jnp.arange(CHUNK, dtype=jnp.float32)
    diff = pos[:, None] - pos[None, :]
    intra_decay = jnp.where(diff[None] >= 0,
                            jnp.exp(jnp.maximum(diff, 0.0)[None] * log_g[:, None, None]),
                            0.0).astype(dt)
    q_dec = jnp.exp((pos[:, None] + 1.0) * log_g[None, :]).astype(dt)
    k_dec = jnp.exp((CHUNK - 1.0 - pos[:, None]) * log_g[None, :]).astype(dt)
    chunk_dec = jnp.exp(CHUNK * log_g).astype(dt)

    sc = jnp.einsum('bnihd,bnjhd->bnhij', qc, kc) * intra_decay[None, None]
    intra = jnp.einsum('bnhij,bnjhe->bnihe', sc, vc)

    def step(R, xs):
        q_n, k_n, v_n = xs
        cross = jnp.einsum('bihd,bhde->bihe', q_n, R) * q_dec[None, :, :, None]
        R_new = (chunk_dec[None, :, None, None] * R
                 + jnp.einsum('bjhd,bjhe->bhde', k_n * k_dec[None, :, :, None], v_n))
        return R_new, cross

    R0 = jnp.zeros((B, R_HEADS, R_DK, R_DV), dtype=dt)
    _, cross = lax.scan(step, R0, (qc.transpose(1, 0, 2, 3, 4),
                                   kc.transpose(1, 0, 2, 3, 4),
                                   vc.transpose(1, 0, 2, 3, 4)))
    o = intra + cross.transpose(1, 0, 2, 3, 4)
    o = rms_norm(o.reshape(B, S, R_HEADS, R_DV), g_gn).reshape(B, S, R_HEADS * R_DV)
    return (jax.nn.silu(gate) * o) @ w_out


def sq_relu_mlp(xn, w1, w2):
    h = jax.nn.relu(xn @ w1)
    return (h * h) @ w2


def setup_inputs(seed: int = 0) -> dict:
    key = jax.random.key(seed)
    ks = jax.random.split(key, 24)
    f32 = jnp.float32

    def nrm(k, shape, scale):
        return jax.random.normal(k, shape, f32) * scale

    def gain(k, shape):
        return 1.0 + 0.02 * jax.random.normal(k, shape, f32)

    return {
        "x": nrm(ks[0], (BATCH, SEQ, D_MODEL), 1.0),
        "p": nrm(ks[1], (DEPTH, BATCH, SEQ, PLE_DIM), 1.0),
        "norm_mix": gain(ks[2], (DEPTH, D_MODEL)),
        "norm_mlp": gain(ks[3], (DEPTH, D_MODEL)),
        "norm_pe": gain(ks[4], (DEPTH, D_MODEL)),
        "a_w_qkv": nrm(ks[5], (N_A_LAYERS, D_MODEL, 3 * D_MODEL), D_MODEL ** -0.5),
        "a_w_o": nrm(ks[6], (N_A_LAYERS, A_HEADS * A_VDIM, D_MODEL), (A_HEADS * A_VDIM) ** -0.5),
        "a_g_q": gain(ks[7], (N_A_LAYERS, A_DHEAD)),
        "a_g_k": gain(ks[8], (N_A_LAYERS, A_DHEAD)),
        "a_lam_q1": nrm(ks[9], (N_A_LAYERS, A_DHEAD), 0.1),
        "a_lam_k1": nrm(ks[10], (N_A_LAYERS, A_DHEAD), 0.1),
        "a_lam_q2": nrm(ks[11], (N_A_LAYERS, A_DHEAD), 0.1),
        "a_lam_k2": nrm(ks[12], (N_A_LAYERS, A_DHEAD), 0.1),
        "a_g_sub": gain(ks[13], (N_A_LAYERS, A_VDIM)),
        "r_w_in": nrm(ks[14], (N_B_LAYERS, D_MODEL, 2 * R_HEADS * R_DK + 2 * R_HEADS * R_DV), D_MODEL ** -0.5),
        "r_w_out": nrm(ks[15], (N_B_LAYERS, R_HEADS * R_DV, D_MODEL), (R_HEADS * R_DV) ** -0.5),
        "r_g_gn": gain(ks[16], (N_B_LAYERS, R_DV)),
        "mlp_w1": nrm(ks[17], (DEPTH, D_MODEL, D_FF), D_MODEL ** -0.5),
        "mlp_w2": nrm(ks[18], (DEPTH, D_FF, D_MODEL), 0.5 * D_FF ** -0.5),
        "pe_w_up": nrm(ks[19], (DEPTH, PLE_DIM, D_MODEL), PLE_DIM ** -0.5),
        "pe_w_gate": nrm(ks[20], (DEPTH, D_MODEL, D_MODEL), D_MODEL ** -0.5),
    }


def reference(x, p, norm_mix, norm_mlp, norm_pe,
              a_w_qkv, a_w_o, a_g_q, a_g_k, a_lam_q1, a_lam_k1, a_lam_q2, a_lam_k2, a_g_sub,
              r_w_in, r_w_out, r_g_gn,
              mlp_w1, mlp_w2, pe_w_up, pe_w_gate):
    for i in range(DEPTH):
        j = i // N_MIXERS
        h = rms_norm(x, norm_mix[i])
        if i % N_MIXERS == 0:
            lambda_init = 0.8 - 0.6 * math.exp(-0.3 * i)
            mix = diff_attention(h, a_w_qkv[j], a_w_o[j], a_g_q[j], a_g_k[j],
                                 a_lam_q1[j], a_lam_k1[j], a_lam_q2[j], a_lam_k2[j],
                                 a_g_sub[j], lambda_init)
        else:
            mix = retention(h, r_w_in[j], r_w_out[j], r_g_gn[j])
        x = x + mix
        x = x + sq_relu_mlp(rms_norm(x, norm_mlp[i]), mlp_w1[i], mlp_w2[i])
        gate = jax.nn.sigmoid(rms_norm(x, norm_pe[i]) @ pe_w_gate[i])
        x = x + gate * (p[i] @ pe_w_up[i])
    return x
```

```cpp
#include <hip/hip_runtime.h>
#include <hip/hip_cooperative_groups.h>
#include <cstdio>
#include <cstdint>
namespace cg = cooperative_groups;
#ifndef GEMM_ALIGN
#define GEMM_ALIGN true
#define GEMM_SP2 true
#endif
namespace pg8 {
#define PG8_LAS __attribute__((address_space(3)))
typedef unsigned short bf16_t;
typedef short bf16x8 __attribute__((ext_vector_type(8)));
typedef float f32x4 __attribute__((ext_vector_type(4)));
typedef unsigned u32x4 __attribute__((ext_vector_type(4)));
constexpr int BM = 256, BK = 64, HALF = 128, HTB = HALF * BK * 2  , STAGE_BYTES = 8 * HTB, NXCD = 8, WGM = 8;

__host__ __device__ __forceinline__ int lds_byte(int r, int c) { const int st = (r >> 4) * 2 + (c >> 5), rr = r & 15, cc = c & 31, ob = rr * 64 + cc * 2; return st * 1024 + (ob ^ (((ob >> 9) & 1) << 5)); }
__host__ __device__ __forceinline__ void stage_rc(int b, int& R, int& C) { const int st = b / 1024, sb = b % 1024, swz = sb ^ (((sb >> 9) & 1) << 5); R = (st >> 1) * 16 + swz / 64; C = (st & 1) * 32 + (swz % 64) / 2; }
__host__ __device__ __forceinline__ int perm32(int rho) { const int n = rho >> 4, i = rho & 15; return 8 * (i >> 2) + 4 * n + (i & 3); }

struct Unit { int pm, pn; };
struct Gemm { const bf16_t* A; const bf16_t* Bt; int M, N, K; };

struct StaticOrder {
    int nM, nN, nwg, G, c;
    __host__ __device__ void init(int M, int N, int G_, int c_) { nM = M / BM; nN = N / BM; nwg = nM * nN; G = G_; c = c_; }
    __host__ __device__ bool next(int i, Unit& u) const {
        const long L = (long)i * G + c; if (L >= nwg) return false;
        int wgid = (int)L; { const int q = nwg / NXCD, r = nwg % NXCD, xcd = wgid % NXCD, off = wgid / NXCD; wgid = (xcd < r ? xcd * (q + 1) : r * (q + 1) + (xcd - r) * q) + off; }
        const int nig = WGM * nN, gid = wgid / nig, fm = gid * WGM, gsz = (nM - fm) < WGM ? (nM - fm) : WGM;
        u.pm = fm + ((wgid % nig) % gsz); u.pn = (wgid % nig) / gsz; return true;
    }
    __device__ __forceinline__ void a_ready(const Unit&) const {}
    __device__ __forceinline__ void done(const Unit&) const {}
};

__device__ __forceinline__ unsigned cvt_pk_bf16(float lo, float hi) { unsigned r; asm volatile("v_cvt_pk_bf16_f32 %0, %1, %2" : "=v"(r) : "v"(lo), "v"(hi)); return r; }
typedef float f32x2 __attribute__((ext_vector_type(2)));
template <class Epi, class Sched, bool ALIGN_EPI = false, bool SP2 = false>
__device__ __forceinline__ void gemm_phase(PG8_LAS unsigned char* lds, const Gemm g, const Sched& S, const Epi& E) {
    int tid = threadIdx.x; asm volatile("" : "+v"(tid)); const int wid = __builtin_amdgcn_readfirstlane(tid >> 6), lane = tid & 63, wr = wid >> 2, wc = wid & 3, fr = lane & 15, fq = lane >> 4;
    const int K = g.K, nt = K / BK;
    unsigned voffA, voffB;
    { int R, C; stage_rc(tid * 16, R, C); const int Rb = Epi::PERM ? ((R & ~31) + perm32(R & 31)) : R;
        voffA = (unsigned)(R * K + C) * 2u; voffB = (unsigned)(Rb * K + C) * 2u; }
    const size_t pstep = (size_t)128 * K;
    const size_t kstep = (size_t)(BK * 2);
    const size_t hstep = (size_t)HALF * K * 2;
    const size_t tstep = 2 * hstep;
    const unsigned ldsw = (unsigned)wid * 1024u;
    const int aoff = lds_byte(wr * 64 + fr, fq * 8), boff = lds_byte(wc * 32 + fr, fq * 8);
#define PG8_SA(b, h) (((b) * 2 + (h)) * HTB)
#define PG8_SB(b, h) ((4 + (b) * 2 + (h)) * HTB)
#define PG8_STAGE(bufoff, gbase, voff) do { _Pragma("unroll") for (int _i = 0; _i < 2; ++_i) \
        __builtin_amdgcn_global_load_lds((const unsigned*)((const char*)(gbase) + _i * pstep + (voff)), (PG8_LAS unsigned*)(lds + (bufoff) + ldsw + _i * 8192), 16, 0, 0); } while (0)
#define PG8_LDA(dst, b, h) do { _Pragma("unroll") for (int m = 0; m < 4; ++m) _Pragma("unroll") for (int k = 0; k < 2; ++k) dst[m][k] = *(const PG8_LAS bf16x8*)(lds + PG8_SA(b, h) + aoff + m * 2048 + k * 1024); } while (0)
#define PG8_LDB(dst, b, h) do { _Pragma("unroll") for (int n = 0; n < 2; ++n) _Pragma("unroll") for (int k = 0; k < 2; ++k) dst[n][k] = *(const PG8_LAS bf16x8*)(lds + PG8_SB(b, h) + boff + n * 2048 + k * 1024); } while (0)
#define PG8_MMA(ai, bj, At, Bt) do { __builtin_amdgcn_s_setprio(1); _Pragma("unroll") for (int m = 0; m < 4; ++m) _Pragma("unroll") for (int n = 0; n < 2; ++n) _Pragma("unroll") for (int k = 0; k < 2; ++k) \
        acc[ai][bj][m][n] = __builtin_amdgcn_mfma_f32_16x16x32_bf16(Bt[n][k], At[m][k], acc[ai][bj][m][n], 0, 0, 0); __builtin_amdgcn_s_setprio(0); } while (0)
#define PG8_WAIT_V(n) asm volatile("s_waitcnt vmcnt(" #n ")" ::: "memory")
#define PG8_WAIT_L(n) asm volatile("s_waitcnt lgkmcnt(" #n ")" ::: "memory")
#define PG8_BAR __builtin_amdgcn_s_barrier()
#define PG8_SCHED __builtin_amdgcn_sched_barrier(0)
    Unit cur, nxt; int ui = 0;
    if (!S.next(0, cur)) return;
    f32x4 acc[2][2][4][2];
#pragma unroll
    for (int a = 0; a < 2; ++a)
#pragma unroll
        for (int b = 0; b < 2; ++b)
#pragma unroll
            for (int m = 0; m < 4; ++m)
#pragma unroll
                for (int n = 0; n < 2; ++n) acc[a][b][m][n] = (f32x4){0.f, 0.f, 0.f, 0.f};
    bf16x8 At[4][2], B0[2][2], B1[2][2];
    const char* cA = (const char*)g.A + (size_t)cur.pm * tstep; const char* cB = (const char*)g.Bt + (size_t)cur.pn * tstep;
    S.a_ready(cur);
    if constexpr (SP2) {
        PG8_STAGE(PG8_SB(0, 0), cB, voffB); PG8_STAGE(PG8_SB(0, 1), cB + hstep, voffB); PG8_STAGE(PG8_SA(0, 0), cA, voffA); PG8_STAGE(PG8_SA(0, 1), cA + hstep, voffA);
        if (wr == 1) PG8_BAR;
        PG8_WAIT_V(2); PG8_BAR;
        PG8_STAGE(PG8_SB(1, 0), cB + kstep, voffB); PG8_STAGE(PG8_SA(1, 0), cA + kstep, voffA); PG8_STAGE(PG8_SB(1, 1), cB + hstep + kstep, voffB);
        PG8_WAIT_V(6); PG8_BAR;
    } else {
        PG8_STAGE(PG8_SB(0, 0), cB, voffB); PG8_STAGE(PG8_SA(0, 0), cA, voffA); PG8_STAGE(PG8_SB(0, 1), cB + hstep, voffB); PG8_STAGE(PG8_SA(0, 1), cA + hstep, voffA);
        if (wr == 1) PG8_BAR;
        PG8_WAIT_V(4); PG8_BAR;
        PG8_STAGE(PG8_SB(1, 0), cB + kstep, voffB); PG8_STAGE(PG8_SA(1, 0), cA + kstep, voffA); PG8_STAGE(PG8_SB(1, 1), cB + hstep + kstep, voffB);
        PG8_WAIT_V(6); PG8_BAR;
    }
    for (;;) {
        const bool has_next = S.next(ui + 1, nxt);
        const char* nA = has_next ? (const char*)g.A + (size_t)nxt.pm * tstep : cA; const char* nB = has_next ? (const char*)g.Bt + (size_t)nxt.pn * tstep : cB;
        for (int t = 0; t < nt; t += 2) {
            const bool last = (t == nt - 2);
            const char* a1 = cA + (size_t)(t + 1) * kstep;
            const char* a2 = last ? nA : cA + (size_t)(t + 2) * kstep; const char* b2 = last ? nB : cB + (size_t)(t + 2) * kstep;
            const char* a3 = a2 + kstep; const char* b3 = b2 + kstep;
            if (last && has_next) S.a_ready(nxt);
            if constexpr (SP2) {
            PG8_LDB(B0, 0, 0); PG8_LDB(B1, 0, 1); PG8_SCHED; PG8_LDA(At, 0, 0); PG8_STAGE(PG8_SA(1, 1), a1 + hstep, voffA);
            PG8_WAIT_V(8); PG8_WAIT_L(0); PG8_BAR; PG8_MMA(0, 0, At, B0); PG8_MMA(0, 1, At, B1); PG8_BAR; PG8_SCHED;
            PG8_LDA(At, 0, 1); PG8_STAGE(PG8_SB(0, 0), b2, voffB); PG8_STAGE(PG8_SB(0, 1), b2 + hstep, voffB); PG8_STAGE(PG8_SA(0, 0), a2, voffA);
            PG8_WAIT_V(8); PG8_WAIT_L(0); PG8_BAR; PG8_MMA(1, 0, At, B0); PG8_MMA(1, 1, At, B1); PG8_BAR; PG8_SCHED;
            PG8_LDB(B0, 1, 0); PG8_LDB(B1, 1, 1); PG8_SCHED; PG8_LDA(At, 1, 0); PG8_STAGE(PG8_SA(0, 1), a2 + hstep, voffA);
            PG8_WAIT_V(8); PG8_WAIT_L(0); PG8_BAR; PG8_MMA(0, 0, At, B0); PG8_MMA(0, 1, At, B1); PG8_BAR; PG8_SCHED;
            PG8_LDA(At, 1, 1); PG8_STAGE(PG8_SB(1, 0), b3, voffB); PG8_STAGE(PG8_SB(1, 1), b3 + hstep, voffB); PG8_STAGE(PG8_SA(1, 0), a3, voffA);
            PG8_WAIT_V(8); PG8_WAIT_L(0); PG8_BAR; PG8_MMA(1, 0, At, B0); PG8_MMA(1, 1, At, B1); PG8_BAR; PG8_SCHED;
            } else {
            PG8_LDB(B0, 0, 0); PG8_SCHED; PG8_LDA(At, 0, 0); PG8_STAGE(PG8_SA(1, 1), a1 + hstep, voffA);
            PG8_WAIT_L(8); PG8_BAR; PG8_WAIT_L(0); PG8_MMA(0, 0, At, B0); PG8_BAR; PG8_SCHED;
            PG8_LDB(B1, 0, 1); PG8_STAGE(PG8_SB(0, 0), b2, voffB);
            PG8_BAR; PG8_WAIT_L(0); PG8_MMA(0, 1, At, B1); PG8_BAR;
            PG8_LDA(At, 0, 1); PG8_STAGE(PG8_SA(0, 0), a2, voffA);
            PG8_BAR; PG8_WAIT_L(0); PG8_MMA(1, 0, At, B0); PG8_BAR; PG8_SCHED;
            PG8_STAGE(PG8_SB(0, 1), b2 + hstep, voffB);
            PG8_WAIT_V(6); PG8_BAR; PG8_MMA(1, 1, At, B1); PG8_BAR;
            PG8_LDB(B0, 1, 0); PG8_SCHED; PG8_LDA(At, 1, 0); PG8_STAGE(PG8_SA(0, 1), a2 + hstep, voffA);
            PG8_WAIT_L(8); PG8_BAR; PG8_WAIT_L(0); PG8_MMA(0, 0, At, B0); PG8_BAR; PG8_SCHED;
            PG8_LDB(B1, 1, 1); PG8_STAGE(PG8_SB(1, 0), b3, voffB);
            PG8_BAR; PG8_WAIT_L(0); PG8_MMA(0, 1, At, B1); PG8_BAR;
            PG8_LDA(At, 1, 1); PG8_STAGE(PG8_SA(1, 0), a3, voffA);
            PG8_BAR; PG8_WAIT_L(0); PG8_MMA(1, 0, At, B0); PG8_BAR; PG8_SCHED;
            PG8_STAGE(PG8_SB(1, 1), b3 + hstep, voffB);
            PG8_WAIT_V(6); PG8_BAR; PG8_MMA(1, 1, At, B1); PG8_BAR;
            }
        }
        if constexpr (ALIGN_EPI) { if (wr == 0) PG8_BAR; }
        if constexpr (!Epi::AFTER_DRAIN) { E(acc, cur, wr, wc, fr, fq); S.done(cur); }
        if (!has_next) break;
#pragma unroll
        for (int a = 0; a < 2; ++a)
#pragma unroll
            for (int b = 0; b < 2; ++b)
#pragma unroll
                for (int m = 0; m < 4; ++m)
#pragma unroll
                    for (int n = 0; n < 2; ++n) acc[a][b][m][n] = (f32x4){0.f, 0.f, 0.f, 0.f};
        cur = nxt; cA = nA; cB = nB; ++ui;
        if constexpr (ALIGN_EPI) { if (wr == 1) PG8_BAR; }
    }
    PG8_WAIT_V(0);
    if constexpr (!ALIGN_EPI) { if (wr == 0) PG8_BAR; }
    PG8_BAR;
    if constexpr (Epi::AFTER_DRAIN) { E.fused(acc, cur, wr, wc, fr, fq, lds, wid, lane); S.done(cur); }
#undef PG8_SA
#undef PG8_SB
#undef PG8_STAGE
#undef PG8_LDA
#undef PG8_LDB
#undef PG8_MMA
#undef PG8_WAIT_V
#undef PG8_WAIT_L
#undef PG8_BAR
#undef PG8_SCHED
}
}

using pg8::bf16_t; using pg8::bf16x8; using pg8::f32x4; using pg8::u32x4;
typedef float f32x16 __attribute__((ext_vector_type(16)));
typedef unsigned u32x2 __attribute__((ext_vector_type(2)));
typedef short s16x4 __attribute__((ext_vector_type(4)));
#define LAS __attribute__((address_space(3)))
constexpr int D = 1024, NBATCH = 16, SEQ = 2048, M = NBATCH * SEQ, FF = 4096, PLE = 256, NWAVES = 8;
constexpr float EPS = 1e-6f, LOG2E = 1.4426950408889634f;
constexpr size_t MiB = 1u << 20;
constexpr size_t WS_SSP0 = 0, WS_SSO = 2 * MiB, WS_WIN = 10 * MiB, WS_WOUT = 22 * MiB, WS_W1 = 26 * MiB, WS_W2 = 34 * MiB, WS_WUP = 42 * MiB, WS_WGATE = 42 * MiB + 512 * 1024,
                 WS_QK0 = 44 * MiB + 512 * 1024, WS_XB = 45 * MiB, WS_PB = 109 * MiB, WS_T = 125 * MiB, WS_SSP1 = 509 * MiB, WS_SIDE = 511 * MiB, WS_END = 512 * MiB;
constexpr int SD_XS = 0, SD_PRJ = 32768, SD_AV = 131072, SD_HS = 163840, SD_US = 229376;
constexpr int LDS_BYTES = 147456;

__device__ __forceinline__ int opaque_tid() { int t = threadIdx.x; asm volatile("" : "+v"(t)); return t; }
__device__ __forceinline__ int opaque_bid() { int t = blockIdx.x; asm volatile("" : "+s"(t)); return t; }
typedef float f32x2_t __attribute__((ext_vector_type(2))); typedef __bf16 bf16x2_t __attribute__((ext_vector_type(2)));
__device__ __forceinline__ unsigned pk2(float lo, float hi) { f32x2_t v = {lo, hi}; bf16x2_t b = __builtin_convertvector(v, bf16x2_t); return __builtin_bit_cast(unsigned, b); }
__device__ __forceinline__ float bf_lo(unsigned w) { return __uint_as_float(w << 16); }
__device__ __forceinline__ float bf_hi(unsigned w) { return __uint_as_float(w & 0xffff0000u); }
__device__ __forceinline__ float fexp2(float x) { return __builtin_amdgcn_exp2f(x); }
__device__ __forceinline__ float sigmoidf_(float z) { return __builtin_amdgcn_rcpf(1.f + fexp2(-z * LOG2E)); }
__device__ __forceinline__ float dot4(f32x4 v) { return (v.x * v.x + v.y * v.y) + (v.z * v.z + v.w * v.w); }
__device__ __forceinline__ float sum4(f32x4 v) { return (v.x + v.y) + (v.z + v.w); }
__device__ __forceinline__ u32x4 pack8(f32x4 a, f32x4 b) { u32x4 w; w.x = pk2(a.x, a.y); w.y = pk2(a.z, a.w); w.z = pk2(b.x, b.y); w.w = pk2(b.z, b.w); return w; }

struct Args {
    const float *x, *p, *norm_mix, *norm_mlp, *norm_pe, *a_w_qkv, *a_w_o, *a_g_q, *a_g_k, *a_lq1, *a_lk1, *a_lq2, *a_lk2, *a_g_sub, *r_w_in, *r_w_out, *r_g_gn, *mlp_w1, *mlp_w2, *pe_w_up, *pe_w_gate;
    float* out; unsigned char* ws;
};

typedef const __attribute__((address_space(4))) Args* KArgs;
__device__ __forceinline__ KArgs kargs() { KArgs p = (KArgs)__builtin_amdgcn_kernarg_segment_ptr(); asm volatile("" : "+s"(p)); return p; }
enum { MODE_PLAIN = 0, MODE_ATTN_QK = 1, MODE_RET_QKG = 2, MODE_SQRELU = 3, MODE_RESID = 4, MODE_GATE = 5, MODE_VT = 6 };
struct EpiG {
    static constexpr bool PERM = true, AFTER_DRAIN = false;
    int mode, layer, sv, xbalt, ret;
    unsigned char* ws;
    __device__ __forceinline__ void operator()(const f32x4 (&acc)[2][2][4][2], const pg8::Unit& u, int wr, int wc, int fr, int fq) const {
        const int lane = fr + 16 * fq;
        const float* ssp = (const float*)(ws + (sv ? WS_SSP1 : WS_SSP0)); float* sspw = (float*)(ws + (sv ? WS_SSP0 : WS_SSP1));
        bf16_t* T0 = (bf16_t*)(ws + WS_T); const size_t E64 = (size_t)32 * MiB;
        bf16_t* o0 = T0; bf16_t* o1 = T0 + E64; bf16_t* o2 = T0 + 4 * E64; int ld0 = D;
        if (mode == MODE_VT) { o0 = T0 + 2 * E64; ld0 = M; } else if (mode == MODE_SQRELU) { ld0 = FF; } else if (mode == MODE_PLAIN) { o0 = T0 + 4 * E64; }
        if (mode == MODE_VT) {
            const int tokL = u.pn * 256 + (lane >> 5) * 128 + wc * 32 + (lane & 31);
            const f32x4* sp = (const f32x4*)(ssp + (size_t)tokL * 16);
            const f32x4 a = sp[0], b = sp[1], c = sp[2], d = sp[3];
            const float s = (sum4(a) + sum4(b)) + (sum4(c) + sum4(d));
            const float rsL = rsqrtf(s * (1.f / 1024.f) + EPS);
            float l2g = 0.f; if (ret) { const int h = u.pm >> 1; l2g = log2f(1.f - fexp2(-5.f - (float)h)); }
#pragma unroll
            for (int bj = 0; bj < 2; ++bj) {
                bf16_t* vbase = T0 + 2 * E64 + (size_t)(u.pm * 256 + wr * 64 + fr) * M + u.pn * 256 + wc * 32 + 8 * fq + bj * 128;
                f32x4 cs[2];
#pragma unroll
                for (int n = 0; n < 2; ++n)
#pragma unroll
                    for (int x = 0; x < 4; ++x) { float v = __shfl(rsL, 32 * bj + 8 * fq + 4 * n + x); if (ret) v *= fexp2(l2g * (float)(127 - (32 * wc + 8 * fq + 4 * n + x))); cs[n][x] = v; }
#pragma unroll
                for (int ai = 0; ai < 2; ++ai)
#pragma unroll
                    for (int m = 0; m < 4; ++m) { bf16_t* rowp = vbase + (size_t)(ai * 128 + m * 16) * M;
                        *(u32x4*)(rowp) = pack8(acc[ai][bj][m][0] * cs[0], acc[ai][bj][m][1] * cs[1]); }
                asm volatile("" ::: "memory");
            }
            return;
        }
        const int row0 = u.pm * 256 + wr * 64 + fr;
        float rs[2][4];
#pragma unroll
        for (int ai = 0; ai < 2; ++ai)
#pragma unroll
            for (int m = 0; m < 4; ++m) { rs[ai][m] = 1.f;
                if (mode != MODE_PLAIN && mode != MODE_RESID) { const int row = row0 + ai * 128 + m * 16; const f32x4 v = *(const f32x4*)(ssp + (size_t)row * 16 + 4 * fq);
                    float s = sum4(v); s += __shfl_xor(s, 16); s += __shfl_xor(s, 32); rs[ai][m] = rsqrtf(s * (1.f / 1024.f) + EPS); } }
        if (mode == MODE_RESID || mode == MODE_GATE) {
            float* X = kargs()->out; const bf16_t* U = T0 + 4 * E64; bf16_t* XBw = xbalt ? (T0 + 5 * E64) : (bf16_t*)(ws + WS_XB);
#pragma unroll
            for (int ai = 0; ai < 2; ++ai)
#pragma unroll
                for (int m = 0; m < 4; ++m) { const int row = row0 + ai * 128 + m * 16; float ss = 0.f; const float r = rs[ai][m]; const bool skip = (row & (SEQ - 1)) == 0;
#pragma unroll
                    for (int bj = 0; bj < 2; ++bj) { const int col0 = u.pn * 256 + bj * 128 + wc * 32 + 8 * fq; float* xp = X + (size_t)row * D + col0;
                        f32x4 x0 = *(const f32x4*)xp, x1 = *(const f32x4*)(xp + 4); f32x4 v0 = acc[ai][bj][m][0], v1 = acc[ai][bj][m][1];
                        if (mode == MODE_GATE) { const u32x4 uw = *(const u32x4*)(U + (size_t)row * D + col0);
                            v0.x = sigmoidf_(v0.x * r) * bf_lo(uw.x); v0.y = sigmoidf_(v0.y * r) * bf_hi(uw.x); v0.z = sigmoidf_(v0.z * r) * bf_lo(uw.y); v0.w = sigmoidf_(v0.w * r) * bf_hi(uw.y);
                            v1.x = sigmoidf_(v1.x * r) * bf_lo(uw.z); v1.y = sigmoidf_(v1.y * r) * bf_hi(uw.z); v1.z = sigmoidf_(v1.z * r) * bf_lo(uw.w); v1.w = sigmoidf_(v1.w * r) * bf_hi(uw.w); }
                        x0 += v0; x1 += v1; ss += dot4(x0) + dot4(x1);
                        if (!skip) { *(f32x4*)xp = x0; *(f32x4*)(xp + 4) = x1; *(u32x4*)(XBw + (size_t)row * D + col0) = pack8(x0, x1); } }
                    ss += __shfl_xor(ss, 16); ss += __shfl_xor(ss, 32);
                    if (fq == 0 && !skip) sspw[(size_t)row * 16 + u.pn * 4 + wc] = ss; }
            return;
        }
        if (mode == MODE_ATTN_QK) {
            const bool isq = u.pn < 4; const float* g = (isq ? kargs()->a_g_q : kargs()->a_g_k) + (layer >> 1) * 64; const float sc = isq ? 0.125f * LOG2E : 1.f;
            bf16_t* base = (isq ? o0 : o1) + (u.pn & 3) * 256 + wc * 64 + 8 * fq;
            f32x4 gv[2][2];
#pragma unroll
            for (int bj = 0; bj < 2; ++bj)
#pragma unroll
                for (int n = 0; n < 2; ++n) gv[bj][n] = *(const f32x4*)(g + 32 * bj + 8 * fq + 4 * n);
#pragma unroll
            for (int ai = 0; ai < 2; ++ai)
#pragma unroll
                for (int m = 0; m < 4; ++m) { const int row = row0 + ai * 128 + m * 16; const float r = rs[ai][m]; f32x4 v[2][2]; float ss = 0.f;
#pragma unroll
                    for (int bj = 0; bj < 2; ++bj)
#pragma unroll
                        for (int n = 0; n < 2; ++n) { v[bj][n] = acc[ai][bj][m][n] * r; ss += dot4(v[bj][n]); }
                    ss += __shfl_xor(ss, 16); ss += __shfl_xor(ss, 32);
                    const float rn = rsqrtf(ss * (1.f / 64.f) + EPS) * sc;
#pragma unroll
                    for (int bj = 0; bj < 2; ++bj) *(u32x4*)(base + (size_t)row * D + 32 * bj) = pack8(v[bj][0] * rn * gv[bj][0], v[bj][1] * rn * gv[bj][1]); }
            return;
        }
        int act = 0, ld = ld0; float sc = 1.f; bf16_t* base = o0 + u.pn * 256;
        if (mode == MODE_RET_QKG) { if (u.pn < 4) { ld = 1024; } else if (u.pn < 8) { base = o1 + (u.pn - 4) * 256; ld = 1024; sc = 0.0625f; } else { base = o2 + (u.pn - 8) * 256; ld = 2048; act = 1; } }
        else if (mode == MODE_SQRELU) { act = 2; }
        base += wc * 32 + 8 * fq;
#pragma unroll
        for (int ai = 0; ai < 2; ++ai)
#pragma unroll
            for (int m = 0; m < 4; ++m) { const int row = row0 + ai * 128 + m * 16; const float r = rs[ai][m] * sc;
#pragma unroll
                for (int bj = 0; bj < 2; ++bj) { f32x4 v0 = acc[ai][bj][m][0] * r, v1 = acc[ai][bj][m][1] * r;
                    if (act == 1) { v0.x *= sigmoidf_(v0.x); v0.y *= sigmoidf_(v0.y); v0.z *= sigmoidf_(v0.z); v0.w *= sigmoidf_(v0.w); v1.x *= sigmoidf_(v1.x); v1.y *= sigmoidf_(v1.y); v1.z *= sigmoidf_(v1.z); v1.w *= sigmoidf_(v1.w); }
                    else if (act == 2) { v0.x = fmaxf(v0.x, 0.f); v0.y = fmaxf(v0.y, 0.f); v0.z = fmaxf(v0.z, 0.f); v0.w = fmaxf(v0.w, 0.f); v1.x = fmaxf(v1.x, 0.f); v1.y = fmaxf(v1.y, 0.f); v1.z = fmaxf(v1.z, 0.f); v1.w = fmaxf(v1.w, 0.f); v0 = v0 * v0; v1 = v1 * v1; }
                    *(u32x4*)(base + (size_t)row * ld + bj * 128) = pack8(v0, v1); } }
    }
};

__device__ __forceinline__ int rowmap(int nn, int rmode) {
    if (rmode == 1) return nn < 2048 ? ((nn & ~255) + ((nn >> 5) & 1) * 128 + ((nn >> 6) & 3) * 32 + (nn & 31)) : nn;
    if (rmode == 2) return nn < 2048 ? nn : (nn < 4096 ? nn + 2048 : nn - 2048);
    return nn;
}
__device__ __forceinline__ void xpose_item(const float* W, int N, int K, bf16_t* WT, int item, int rmode, const float* gain, int gmask, float gscale, LAS float* scr, int lane) {
    const int nblk = N / 32, kb = item / nblk, nb = item - kb * nblk, k0 = 64 * kb, n0 = 32 * nb;
#pragma unroll 8
    for (int i = 0; i < 32; ++i) { const int kk = 2 * i + (lane >> 5); float v = W[(size_t)(k0 + kk) * N + n0 + (lane & 31)]; if (gain) v *= gain[(k0 + kk) & gmask] * gscale; scr[kk * 33 + (lane & 31)] = v; }
    asm volatile("s_waitcnt lgkmcnt(0)" ::: "memory");
    const int c = lane & 7;
#pragma unroll
    for (int j = 0; j < 4; ++j) { const int n = (lane >> 3) + 8 * j; const LAS float* s = scr + (8 * c) * 33 + n; const int row = rowmap(n0 + n, rmode);
        u32x4 o; o.x = pk2(s[0 * 33], s[1 * 33]); o.y = pk2(s[2 * 33], s[3 * 33]); o.z = pk2(s[4 * 33], s[5 * 33]); o.w = pk2(s[6 * 33], s[7 * 33]);
        *(u32x4*)(WT + (size_t)row * K + k0 + 8 * c) = o; }
    asm volatile("s_waitcnt lgkmcnt(0)" ::: "memory");
}

__device__ __forceinline__ float lambda_init_of(int i) { asm volatile("" : "+s"(i)); return i == 0 ? 0.2f : 0.47071301834f; }

__device__ __forceinline__ void convert_in(int i, LAS unsigned char* lds, int G) {
    KArgs a = kargs();
    const int tid = opaque_tid(), lane = tid & 63, wave = __builtin_amdgcn_readfirstlane(tid >> 6), gw = opaque_bid() * NWAVES + wave, ngw = G * NWAVES;
    LAS float* scr = (LAS float*)(lds + wave * 16384); const int j = i >> 1;
    bf16_t* WT = (bf16_t*)(a->ws + WS_WIN); const float* gain = a->norm_mix + i * D;
    if ((i & 1) == 0) { const float* W = a->a_w_qkv + (size_t)j * D * 3072; for (int it = gw; it < 16 * 96; it += ngw) xpose_item(W, 3072, D, WT, it, 1, gain, 1023, 1.f, scr, lane); }
    else { const float* W = a->r_w_in + (size_t)j * D * 6144; for (int it = gw; it < 16 * 192; it += ngw) xpose_item(W, 6144, D, WT, it, 2, gain, 1023, 1.f, scr, lane); }
}
__device__ __forceinline__ void convert_rest(int i, LAS unsigned char* lds, int G) {
    KArgs a = kargs();
    const int tid = opaque_tid(), lane = tid & 63, wave = __builtin_amdgcn_readfirstlane(tid >> 6), gw = opaque_bid() * NWAVES + wave, ngw = G * NWAVES;
    LAS float* scr = (LAS float*)(lds + wave * 16384); const int j = i >> 1; const bool attn = (i & 1) == 0;
    const int n_out = attn ? 512 : 1024, n_1 = 2048, n_2 = 2048, n_up = 128, n_g = 512, total = n_out + n_1 + n_2 + n_up + n_g;
    for (int it = gw; it < total; it += ngw) {
        int r = it;
        if (r < n_out) { if (attn) xpose_item(a->a_w_o + (size_t)j * D * D, D, D, (bf16_t*)(a->ws + WS_WOUT), r, 0, a->a_g_sub + j * 128, 127, 1.f - lambda_init_of(i), scr, lane);
                         else xpose_item(a->r_w_out + (size_t)j * 2048 * D, D, 2048, (bf16_t*)(a->ws + WS_WOUT), r, 0, a->r_g_gn + j * 512, 511, 1.f, scr, lane); continue; } r -= n_out;
        if (r < n_1) { xpose_item(a->mlp_w1 + (size_t)i * D * FF, FF, D, (bf16_t*)(a->ws + WS_W1), r, 0, a->norm_mlp + i * D, 1023, 1.f, scr, lane); continue; } r -= n_1;
        if (r < n_2) { xpose_item(a->mlp_w2 + (size_t)i * FF * D, D, FF, (bf16_t*)(a->ws + WS_W2), r, 0, nullptr, 0, 1.f, scr, lane); continue; } r -= n_2;
        if (r < n_up) { xpose_item(a->pe_w_up + (size_t)i * PLE * D, D, PLE, (bf16_t*)(a->ws + WS_WUP), r, 0, nullptr, 0, 1.f, scr, lane); continue; } r -= n_up;
        xpose_item(a->pe_w_gate + (size_t)i * D * D, D, D, (bf16_t*)(a->ws + WS_WGATE), r, 0, a->norm_pe + i * D, 1023, 1.f, scr, lane);
    }
    const f32x4* ps = (const f32x4*)(a->p + (size_t)i * M * PLE); u32x4* pd = (u32x4*)(a->ws + WS_PB);
    const int gt = gw * 64 + lane, ngt = ngw * 64;
    for (int q = gt; q < M * PLE / 8; q += ngt) { const f32x4 v0 = ps[2 * q], v1 = ps[2 * q + 1]; pd[q] = pack8(v0, v1); }
}

__device__ __forceinline__ void prologue_rows(int G) {
    KArgs a = kargs();
    const int tid = opaque_tid(), lane = tid & 63, wave = __builtin_amdgcn_readfirstlane(tid >> 6), gw = opaque_bid() * NWAVES + wave, ngw = G * NWAVES;
    float* ssp = (float*)(a->ws + WS_SSP0); bf16_t* XB = (bf16_t*)(a->ws + WS_XB);
    for (int m = gw; m < M; m += ngw) {
        const f32x4* xr = (const f32x4*)(a->x + (size_t)m * D) + lane; f32x4* xo = (f32x4*)(a->out + (size_t)m * D) + lane; u32x2* xb = (u32x2*)(XB + (size_t)m * D) + lane;
        float s = 0.f;
#pragma unroll
        for (int j = 0; j < 4; ++j) { const f32x4 v = xr[64 * j]; xo[64 * j] = v; s += dot4(v); u32x2 w; w.x = pk2(v.x, v.y); w.y = pk2(v.z, v.w); xb[64 * j] = w; }
#pragma unroll
        for (int o = 1; o < 64; o <<= 1) s += __shfl_xor(s, o);
        if (lane < 16) ssp[(size_t)m * 16 + lane] = (lane == 0) ? s : 0.f;
    }
    if (gw < NBATCH) { const float* xr = a->x + (size_t)gw * SEQ * D; float* xs0 = (float*)(a->ws + WS_SIDE) + SD_XS + gw * D;
        for (int k = lane; k < D; k += 64) xs0[k] = xr[k]; }
}

__device__ __forceinline__ void attn_phase(LAS unsigned char* lds, const bf16_t* Q, const bf16_t* K, const bf16_t* VT, bf16_t* O, float lam, int G) {
    const int tid = opaque_tid(), lane = tid & 63, w = __builtin_amdgcn_readfirstlane(tid >> 6), r = lane & 31, hh = lane >> 5;
    LAS unsigned char* Ks = lds; LAS unsigned char* Vs = lds + 64 * 272; LAS unsigned char* Qs = lds + 36864 + w * 8704 + r * 272 + 16 * hh;
    for (int v = opaque_bid(); v < 256; v += G) {
        const int xcd = v & 7, slot = v >> 3, bh = xcd * 16 + (slot >> 1), par = slot & 1, b = bh >> 3, h = bh & 7;
        const float slope2 = fexp2(-(float)(h + 1)) * LOG2E;
        const size_t tokb = (size_t)b * SEQ;
        for (int ui = 0; ui < 4; ++ui) {
            const int qb = par ? (ui == 0 ? 1 : ui == 1 ? 2 : ui == 2 ? 5 : 6) : (ui == 0 ? 0 : ui == 1 ? 3 : ui == 2 ? 4 : 7);
            const int q0 = qb * 256, q0w = q0 + 32 * w, nt = (q0 + 256) >> 6;
            { const int t2 = opaque_tid(); const bf16_t* qp = Q + (tokb + q0w + (t2 & 31)) * D + h * 128 + 8 * ((t2 >> 5) & 1);
#pragma unroll
              for (int c = 0; c < 2; ++c)
#pragma unroll
                  for (int ks = 0; ks < 4; ++ks) *(LAS bf16x8*)(Qs + (c * 64 + 16 * ks) * 2) = *(const bf16x8*)(qp + c * 64 + 16 * ks); }
            f32x16 o[2][4];
#pragma unroll
            for (int c = 0; c < 2; ++c)
#pragma unroll
                for (int et = 0; et < 4; ++et)
#pragma unroll
                    for (int g = 0; g < 16; ++g) o[c][et][g] = 0.f;
            float mrun[2] = {-1e30f, -1e30f}, lrun[2] = {0.f, 0.f};
            const int kl0 = (tid >> 4) * 272 + (tid & 15) * 16, vl0 = (tid >> 3) * 144 + (tid & 7) * 16;
            const bf16_t* kgb = K + tokb * D + h * 128; const unsigned kof = (unsigned)((tid >> 4) * D + (tid & 15) * 8);
            const bf16_t* vgb = VT + (size_t)(h * 128) * M + tokb; const unsigned vof = (unsigned)((tid >> 3) * M + (tid & 7) * 8);
            for (int t = 0; t < nt; ++t) {
                u32x4 kreg[2], vreg[2];
#pragma unroll
                for (int i = 0; i < 2; ++i) { kreg[i] = *(const u32x4*)(kgb + ((size_t)32 * i * D + (size_t)t * 64 * D) + kof); vreg[i] = *(const u32x4*)(vgb + ((size_t)64 * i * M + t * 64) + vof); }
                __syncthreads();
#pragma unroll
                for (int i = 0; i < 2; ++i) { *(LAS u32x4*)(Ks + kl0 + 32 * i * 272) = kreg[i]; *(LAS u32x4*)(Vs + vl0 + 64 * i * 144) = vreg[i]; }
                __syncthreads();
#pragma unroll
                for (int half = 0; half < 2; ++half) {
                    const int kb = 64 * t + 32 * half;
                    if (kb <= q0w) {
                        const bool diag = (kb == q0w);
                        const float base = slope2 * (float)(kb + 4 * hh);
#pragma unroll
                        for (int c = 0; c < 2; ++c) {
                            f32x16 s;
#pragma unroll
                            for (int g = 0; g < 16; ++g) s[g] = fmaf(slope2, (float)((g & 3) + 8 * (g >> 2)), base);
#pragma unroll
                            for (int ks = 0; ks < 4; ++ks) { const bf16x8 af = *(const LAS bf16x8*)(Ks + (32 * half + r) * 272 + (c * 64 + 16 * ks + 8 * hh) * 2);
                                const bf16x8 bq = *(const LAS bf16x8*)(Qs + (c * 64 + 16 * ks) * 2);
                                s = __builtin_amdgcn_mfma_f32_32x32x16_bf16(af, bq, s, 0, 0, 0); }
                            if (diag) { int rr = r - 4 * hh; asm volatile("" : "+v"(rr));
#pragma unroll
                                for (int g = 0; g < 16; ++g) if ((g & 3) + 8 * (g >> 2) > rr) s[g] = -1e30f; }
                            float mx = s[0];
#pragma unroll
                            for (int g = 1; g < 16; ++g) mx = fmaxf(mx, s[g]);
                            mx = fmaxf(mx, __shfl_xor(mx, 32));
                            const float mnew = fmaxf(mrun[c], mx), alpha = fexp2(mrun[c] - mnew); mrun[c] = mnew;
                            float rsum = 0.f;
#pragma unroll
                            for (int g = 0; g < 16; ++g) { s[g] = fexp2(s[g] - mnew); rsum += s[g]; }
                            lrun[c] = lrun[c] * alpha + rsum;
                            if (__any(alpha != 1.f)) {
#pragma unroll
                                for (int et = 0; et < 4; ++et)
#pragma unroll
                                    for (int g = 0; g < 16; ++g) o[c][et][g] *= alpha; }
                            u32x4 pw0, pw1;
                            pw0.x = pk2(s[0], s[1]); pw0.y = pk2(s[2], s[3]); pw0.z = pk2(s[4], s[5]); pw0.w = pk2(s[6], s[7]);
                            pw1.x = pk2(s[8], s[9]); pw1.y = pk2(s[10], s[11]); pw1.z = pk2(s[12], s[13]); pw1.w = pk2(s[14], s[15]);
                            const bf16x8 pb0 = __builtin_bit_cast(bf16x8, pw0), pb1 = __builtin_bit_cast(bf16x8, pw1);
#pragma unroll
                            for (int et = 0; et < 4; ++et) { const LAS unsigned char* vp = Vs + (32 * et + r) * 144 + (32 * half + 4 * hh) * 2;
                                const s16x4 a0 = *(const LAS s16x4*)(vp), a1 = *(const LAS s16x4*)(vp + 16), a2 = *(const LAS s16x4*)(vp + 32), a3 = *(const LAS s16x4*)(vp + 48);
                                o[c][et] = __builtin_amdgcn_mfma_f32_32x32x16_bf16(__builtin_shufflevector(a0, a1, 0, 1, 2, 3, 4, 5, 6, 7), pb0, o[c][et], 0, 0, 0);
                                o[c][et] = __builtin_amdgcn_mfma_f32_32x32x16_bf16(__builtin_shufflevector(a2, a3, 0, 1, 2, 3, 4, 5, 6, 7), pb1, o[c][et], 0, 0, 0); }
                        }
                    }
                }
            }
            const float l0 = lrun[0] + __shfl_xor(lrun[0], 32), l1 = lrun[1] + __shfl_xor(lrun[1], 32);
            const float i0 = 1.f / l0, i1 = lam / l1; float ss = 0.f;
#pragma unroll
            for (int et = 0; et < 4; ++et)
#pragma unroll
                for (int g = 0; g < 16; ++g) { const float vv = o[0][et][g] * i0 - o[1][et][g] * i1; o[0][et][g] = vv; ss += vv * vv; }
            ss += __shfl_xor(ss, 32);
            const float rn = rsqrtf(ss * (1.f / 128.f) + EPS);
            const int t2 = opaque_tid();
            bf16_t* op = O + (tokb + q0w + (t2 & 31)) * D + h * 128 + 4 * ((t2 >> 5) & 1);
#pragma unroll
            for (int et = 0; et < 4; ++et)
#pragma unroll
                for (int g = 0; g < 4; ++g) { u32x2 wv; wv.x = pk2(o[0][et][4 * g] * rn, o[0][et][4 * g + 1] * rn); wv.y = pk2(o[0][et][4 * g + 2] * rn, o[0][et][4 * g + 3] * rn);
                    *(u32x2*)(op + 32 * et + 8 * g) = wv; }
        }
    }
}

__device__ __forceinline__ void ret_phase(LAS unsigned char* lds, const bf16_t* Q, const bf16_t* K, const bf16_t* VT, bf16_t* TG, float* SSO, int G) {
    const int tid = opaque_tid(), lane = tid & 63, w = __builtin_amdgcn_readfirstlane(tid >> 6), r = lane & 31, hh = lane >> 5;
    const int ib = w & 3, eb = w >> 2, db = w;
    LAS unsigned char* Kn = lds; LAS unsigned char* Vn = lds + 128 * 528; LAS unsigned char* RT = lds + 128 * 528 + 64 * 272;
    for (int v = opaque_bid(); v < 256; v += G) {
        const int xcd = v & 7, slot = v >> 3;
        for (int k2 = 0; k2 < 2; ++k2) {
            const int jj = slot + 32 * k2, bh = xcd * 8 + (jj >> 3), vs = jj & 7, b = bh >> 2, h = bh & 3;
            const float l2g = log2f(1.f - fexp2(-5.f - (float)h)), cdec = fexp2(128.f * l2g);
            const size_t tokb = (size_t)b * SEQ;
            f32x16 racc[2];
#pragma unroll
            for (int e2 = 0; e2 < 2; ++e2)
#pragma unroll
                for (int g = 0; g < 16; ++g) racc[e2][g] = 0.f;
            __syncthreads();
            for (int q = tid; q < 64 * 528 / 16; q += 512) *(LAS u32x4*)(RT + q * 16) = (u32x4){0u, 0u, 0u, 0u};
            const int kl0 = (tid >> 5) * 528 + (tid & 31) * 16, vl0 = (tid >> 4) * 272 + (tid & 15) * 16;
            const bf16_t* kg0 = K + (tokb + (tid >> 5)) * D + h * 256 + (tid & 31) * 8;
            const bf16_t* vg0 = VT + (size_t)(h * 512 + vs * 64 + (tid >> 4)) * M + tokb + (tid & 15) * 8;
            u32x4 kreg[8], vreg[2];
#pragma unroll
            for (int i = 0; i < 8; ++i) kreg[i] = *(const u32x4*)(kg0 + (size_t)16 * i * D);
#pragma unroll
            for (int i = 0; i < 2; ++i) vreg[i] = *(const u32x4*)(vg0 + (size_t)32 * i * M);
            for (int n = 0; n < 16; ++n) {
                const size_t tok0 = tokb + 128 * n;
#pragma unroll
                for (int i = 0; i < 8; ++i) *(LAS u32x4*)(Kn + kl0 + 16 * i * 528) = kreg[i];
#pragma unroll
                for (int i = 0; i < 2; ++i) *(LAS u32x4*)(Vn + vl0 + 32 * i * 272) = vreg[i];
                __syncthreads();
                if (n + 1 < 16) {
#pragma unroll
                    for (int i = 0; i < 8; ++i) kreg[i] = *(const u32x4*)(kg0 + (size_t)16 * i * D + (size_t)(n + 1) * 128 * D);
#pragma unroll
                    for (int i = 0; i < 2; ++i) vreg[i] = *(const u32x4*)(vg0 + (size_t)32 * i * M + (n + 1) * 128); }
                bf16x8 qf[16];
                { const bf16_t* qp = Q + (tok0 + 32 * ib + r) * D + h * 256 + 8 * hh;
#pragma unroll
                  for (int s = 0; s < 16; ++s) qf[s] = *(const bf16x8*)(qp + 16 * s); }
                f32x16 acc;
#pragma unroll
                for (int g = 0; g < 16; ++g) acc[g] = 0.f;
#pragma unroll
                for (int s = 0; s < 16; ++s) { const bf16x8 af = *(const LAS bf16x8*)(RT + (32 * eb + r) * 528 + (16 * s + 8 * hh) * 2); acc = __builtin_amdgcn_mfma_f32_32x32x16_bf16(af, qf[s], acc, 0, 0, 0); }
#pragma unroll
                for (int g = 0; g < 16; ++g) acc[g] *= cdec;
                for (int jb = 0; jb <= ib; ++jb) {
                    f32x16 st;
#pragma unroll
                    for (int g = 0; g < 16; ++g) st[g] = 0.f;
#pragma unroll
                    for (int s = 0; s < 16; ++s) { const bf16x8 af = *(const LAS bf16x8*)(Kn + (32 * jb + r) * 528 + (16 * s + 8 * hh) * 2); st = __builtin_amdgcn_mfma_f32_32x32x16_bf16(af, qf[s], st, 0, 0, 0); }
                    if (jb == ib) { int rr = r - 4 * hh; asm volatile("" : "+v"(rr));
#pragma unroll
                        for (int g = 0; g < 16; ++g) if ((g & 3) + 8 * (g >> 2) > rr) st[g] = 0.f; }
                    u32x4 pw0, pw1;
                    pw0.x = pk2(st[0], st[1]); pw0.y = pk2(st[2], st[3]); pw0.z = pk2(st[4], st[5]); pw0.w = pk2(st[6], st[7]);
                    pw1.x = pk2(st[8], st[9]); pw1.y = pk2(st[10], st[11]); pw1.z = pk2(st[12], st[13]); pw1.w = pk2(st[14], st[15]);
                    const LAS unsigned char* vp = Vn + (32 * eb + r) * 272 + (32 * jb + 4 * hh) * 2;
                    const s16x4 a0 = *(const LAS s16x4*)(vp), a1 = *(const LAS s16x4*)(vp + 16), a2 = *(const LAS s16x4*)(vp + 32), a3 = *(const LAS s16x4*)(vp + 48);
                    acc = __builtin_amdgcn_mfma_f32_32x32x16_bf16(__builtin_shufflevector(a0, a1, 0, 1, 2, 3, 4, 5, 6, 7), __builtin_bit_cast(bf16x8, pw0), acc, 0, 0, 0);
                    acc = __builtin_amdgcn_mfma_f32_32x32x16_bf16(__builtin_shufflevector(a2, a3, 0, 1, 2, 3, 4, 5, 6, 7), __builtin_bit_cast(bf16x8, pw1), acc, 0, 0, 0);
                }
                { const int i = 32 * ib + r; const float fac = fexp2(l2g * (float)(i - 127)); float ss = 0.f;
#pragma unroll
                  for (int g = 0; g < 16; ++g) { acc[g] *= fac; ss += acc[g] * acc[g]; }
                  ss += __shfl_xor(ss, 32);
                  const size_t tok = tok0 + i;
                  if (hh == 0) SSO[tok * 64 + h * 16 + vs * 2 + eb] = ss;
                  bf16_t* gp = TG + tok * 2048 + h * 512 + vs * 64 + 32 * eb + 4 * hh;
#pragma unroll
                  for (int g = 0; g < 4; ++g) { const u32x2 gw = *(const u32x2*)(gp + 8 * g); u32x2 ov;
                      ov.x = pk2(acc[4 * g] * bf_lo(gw.x), acc[4 * g + 1] * bf_hi(gw.x)); ov.y = pk2(acc[4 * g + 2] * bf_lo(gw.y), acc[4 * g + 3] * bf_hi(gw.y)); *(u32x2*)(gp + 8 * g) = ov; } }
#pragma unroll
                for (int e2 = 0; e2 < 2; ++e2)
#pragma unroll
                    for (int g = 0; g < 16; ++g) racc[e2][g] *= cdec;
#pragma unroll
                for (int s = 0; s < 8; ++s) { const LAS unsigned short* kp = (const LAS unsigned short*)Kn + (16 * s + 8 * hh) * 264 + 32 * db + r;
                    u32x4 aw;
                    aw.x = (unsigned)kp[0] | ((unsigned)kp[264] << 16); aw.y = (unsigned)kp[2 * 264] | ((unsigned)kp[3 * 264] << 16);
                    aw.z = (unsigned)kp[4 * 264] | ((unsigned)kp[5 * 264] << 16); aw.w = (unsigned)kp[6 * 264] | ((unsigned)kp[7 * 264] << 16);
                    const bf16x8 af = __builtin_bit_cast(bf16x8, aw);
#pragma unroll
                    for (int e2 = 0; e2 < 2; ++e2) { const bf16x8 bb = *(const LAS bf16x8*)(Vn + (32 * e2 + r) * 272 + (16 * s + 8 * hh) * 2); racc[e2] = __builtin_amdgcn_mfma_f32_32x32x16_bf16(af, bb, racc[e2], 0, 0, 0); } }
                __syncthreads();
#pragma unroll
                for (int e2 = 0; e2 < 2; ++e2)
#pragma unroll
                    for (int g = 0; g < 4; ++g) { u32x2 wv; wv.x = pk2(racc[e2][4 * g], racc[e2][4 * g + 1]); wv.y = pk2(racc[e2][4 * g + 2], racc[e2][4 * g + 3]);
                        *(LAS u32x2*)(RT + (32 * e2 + r) * 528 + (32 * db + 8 * g + 4 * hh) * 2) = wv; }
            }
        }
    }
}


__device__ __forceinline__ float bf2f(bf16_t v) { return __uint_as_float((unsigned)v << 16); }
__device__ __forceinline__ void attn_naive(const bf16_t* Q, const bf16_t* K, const bf16_t* VT, bf16_t* O, float lam, int G) {
    const int tid = opaque_tid(), lane = tid & 63, wave = __builtin_amdgcn_readfirstlane(tid >> 6), gw = opaque_bid() * NWAVES + wave, ngw = G * NWAVES;
    for (int row = gw; row < NBATCH * 8 * SEQ; row += ngw) {
        const int q = row % SEQ, bh = row / SEQ, h = bh & 7, b = bh >> 3; const size_t tokb = (size_t)b * SEQ;
        const float slope2 = fexp2(-(float)(h + 1)) * LOG2E;
        float oc[2][2]; float res0 = 0.f, res1 = 0.f;
        for (int c = 0; c < 2; ++c) {
            const bf16_t* qp = Q + (tokb + q) * D + h * 128 + c * 64;
            float m = -1e30f, l = 0.f;
            for (int k0 = 0; k0 <= q; k0 += 64) { const int k = k0 + lane; float sc = -1e30f;
                if (k <= q) { const bf16_t* kp = K + (tokb + k) * D + h * 128 + c * 64; float d = 0.f; for (int t = 0; t < 64; ++t) d = fmaf(bf2f(qp[t]), bf2f(kp[t]), d); sc = d + slope2 * (float)k; }
                const float mn = fmaxf(m, sc); l = l * fexp2(m - mn) + ((k <= q) ? fexp2(sc - mn) : 0.f); m = mn; }
            float mg = m;
#pragma unroll
            for (int o = 1; o < 64; o <<= 1) mg = fmaxf(mg, __shfl_xor(mg, o));
            l = l * fexp2(m - mg);
#pragma unroll
            for (int o = 1; o < 64; o <<= 1) l += __shfl_xor(l, o);
            float o0 = 0.f, o1 = 0.f;
            for (int k0 = 0; k0 <= q; k0 += 64) { const int k = k0 + lane; float pv = 0.f;
                if (k <= q) { const bf16_t* kp = K + (tokb + k) * D + h * 128 + c * 64; float d = 0.f; for (int t = 0; t < 64; ++t) d = fmaf(bf2f(qp[t]), bf2f(kp[t]), d); pv = fexp2(d + slope2 * (float)k - mg); }
                const int nk = (q - k0 + 1) < 64 ? (q - k0 + 1) : 64;
                for (int jj = 0; jj < nk; ++jj) { const float pj = __shfl(pv, jj); const size_t tk = tokb + k0 + jj;
                    o0 = fmaf(pj, bf2f(VT[(size_t)(h * 128 + lane) * M + tk]), o0); o1 = fmaf(pj, bf2f(VT[(size_t)(h * 128 + 64 + lane) * M + tk]), o1); } }
            oc[c][0] = o0 / l; oc[c][1] = o1 / l;
        }
        res0 = oc[0][0] - lam * oc[1][0]; res1 = oc[0][1] - lam * oc[1][1];
        float ss = res0 * res0 + res1 * res1;
#pragma unroll
        for (int o = 1; o < 64; o <<= 1) ss += __shfl_xor(ss, o);
        const float rn = rsqrtf(ss * (1.f / 128.f) + EPS);
        bf16_t* op = O + (tokb + q) * D + h * 128;
        op[lane] = (bf16_t)(pk2(res0 * rn, 0.f) & 0xffffu); op[64 + lane] = (bf16_t)(pk2(res1 * rn, 0.f) & 0xffffu);
    }
}
__device__ __forceinline__ void ret_naive(const bf16_t* Q, const bf16_t* K, const bf16_t* VT, bf16_t* TG, float* SSO, int G) {
    const int tid = opaque_tid(), lane = tid & 63, wave = __builtin_amdgcn_readfirstlane(tid >> 6), gw = opaque_bid() * NWAVES + wave, ngw = G * NWAVES;
    for (int row = gw; row < NBATCH * 4 * SEQ; row += ngw) {
        const int i = row % SEQ, bh = row / SEQ, h = bh & 3, b = bh >> 2; const size_t tokb = (size_t)b * SEQ;
        const float l2g = log2f(1.f - fexp2(-5.f - (float)h));
        const bf16_t* qp = Q + (tokb + i) * D + h * 256;
        float o[8];
#pragma unroll
        for (int t = 0; t < 8; ++t) o[t] = 0.f;
        for (int j0 = 0; j0 <= i; j0 += 64) { const int j = j0 + lane; float wv = 0.f;
            if (j <= i) { const bf16_t* kp = K + (tokb + j) * D + h * 256; float d = 0.f; for (int t = 0; t < 256; ++t) d = fmaf(bf2f(qp[t]), bf2f(kp[t]), d);
                wv = d * fexp2(l2g * (float)((i - j) - (127 - (j & 127)))); }
            const int nj = (i - j0 + 1) < 64 ? (i - j0 + 1) : 64;
            for (int jj = 0; jj < nj; ++jj) { const float wj = __shfl(wv, jj); const size_t tk = tokb + j0 + jj;
#pragma unroll
                for (int t = 0; t < 8; ++t) o[t] = fmaf(wj, bf2f(VT[(size_t)(h * 512 + 64 * t + lane) * M + tk]), o[t]); } }
        float ss = 0.f;
#pragma unroll
        for (int t = 0; t < 8; ++t) ss += o[t] * o[t];
#pragma unroll
        for (int of = 1; of < 64; of <<= 1) ss += __shfl_xor(ss, of);
        const size_t tok = tokb + i;
        if (lane < 16) SSO[tok * 64 + h * 16 + lane] = (lane == 0) ? ss : 0.f;
        bf16_t* gp = TG + tok * 2048 + h * 512;
#pragma unroll
        for (int t = 0; t < 8; ++t) gp[64 * t + lane] = (bf16_t)(pk2(o[t] * bf2f(gp[64 * t + lane]), 0.f) & 0xffffu);
    }
}

__device__ __forceinline__ void ret_norm_phase(bf16_t* TG, const float* SSO, int G) {
    const int tid = opaque_tid(), lane = tid & 63, wave = __builtin_amdgcn_readfirstlane(tid >> 6), gw = opaque_bid() * NWAVES + wave, ngw = G * NWAVES;
    for (int idx = gw; idx < M * 4; idx += ngw) {
        float s = (lane < 16) ? SSO[(size_t)idx * 16 + lane] : 0.f;
#pragma unroll
        for (int o = 1; o < 16; o <<= 1) s += __shfl_xor(s, o);
        s = __shfl(s, 0);
        const float rn = rsqrtf(s * (1.f / 512.f) + EPS);
        u32x4* p = (u32x4*)(TG + (size_t)idx * 512) + lane; const u32x4 v = *p; u32x4 o;
        o.x = pk2(bf_lo(v.x) * rn, bf_hi(v.x) * rn); o.y = pk2(bf_lo(v.y) * rn, bf_hi(v.y) * rn); o.z = pk2(bf_lo(v.z) * rn, bf_hi(v.z) * rn); o.w = pk2(bf_lo(v.w) * rn, bf_hi(v.w) * rn);
        *p = o;
    }
}


enum { SK_PROJ = 0, SK_OUT = 1, SK_W1 = 2, SK_UP = 3, SK_W2 = 4, SK_GATE = 5 };
__device__ __forceinline__ void side_step(int kind, int i, int sv, LAS unsigned char* lds, int G) {
    KArgs a = kargs(); const int tid = opaque_tid(), lane = tid & 63, wave = __builtin_amdgcn_readfirstlane(tid >> 6), bid = opaque_bid();
    float* SD = (float*)(a->ws + WS_SIDE);
    float* XSc = SD + SD_XS + (sv ? 16384 : 0); float* XSn = SD + SD_XS + (sv ? 0 : 16384);
    const bool attn = (i & 1) == 0; const int j = i >> 1;
    const float* xin = XSc; int xs = 1024, K = 1024, ldw = 1024, nitems = 16; const float* gain = nullptr; const float* W = nullptr;
    if (kind == SK_PROJ) { gain = a->norm_mix + i * D; if (attn) { W = a->a_w_qkv + (size_t)j * D * 3072 + 2048; ldw = 3072; } else { W = a->r_w_in + (size_t)j * D * 6144; ldw = 6144; nitems = 96; } }
    else if (kind == SK_OUT) { xin = SD + SD_AV; xs = 2048; if (attn) { W = a->a_w_o + (size_t)j * D * D; } else { K = 2048; W = a->r_w_out + (size_t)j * 2048 * D; } }
    else if (kind == SK_W1) { gain = a->norm_mlp + i * D; W = a->mlp_w1 + (size_t)i * D * FF; ldw = FF; nitems = 64; }
    else if (kind == SK_UP) { xin = a->p + (size_t)i * M * PLE; xs = SEQ * PLE; K = PLE; W = a->pe_w_up + (size_t)i * PLE * D; }
    else if (kind == SK_W2) { xin = SD + SD_HS; xs = FF; K = FF; W = a->mlp_w2 + (size_t)i * FF * D; }
    else { gain = a->norm_pe + i * D; W = a->pe_w_gate + (size_t)i * D * D; }
    LAS float* part = (LAS float*)lds;
    for (int it = bid; it < nitems; it += G) {
        const int n0 = it * 64, kper = K >> 3, kb0 = wave * kper;
        float acc[16];
#pragma unroll
        for (int b = 0; b < 16; ++b) acc[b] = 0.f;
        for (int k = kb0; k < kb0 + kper; k += 4) {
            float w4[4];
#pragma unroll
            for (int jj = 0; jj < 4; ++jj) { w4[jj] = W[(size_t)(k + jj) * ldw + n0 + lane]; if (gain) w4[jj] *= gain[k + jj]; }
#pragma unroll
            for (int b = 0; b < 16; ++b) { const f32x4 xv = *(const f32x4*)(xin + (size_t)b * xs + k); acc[b] = fmaf(xv.x, w4[0], fmaf(xv.y, w4[1], fmaf(xv.z, w4[2], fmaf(xv.w, w4[3], acc[b])))); }
        }
#pragma unroll
        for (int b = 0; b < 16; ++b) part[(wave * 16 + b) * 64 + lane] = acc[b];
        __syncthreads();
#pragma unroll
        for (int rr = 0; rr < 2; ++rr) { const int b = 2 * wave + rr; float v = 0.f;
#pragma unroll
            for (int w2 = 0; w2 < 8; ++w2) v += part[(w2 * 16 + b) * 64 + lane];
            if (gain) { float sq = 0.f; for (int k = lane; k < D; k += 64) { const float xv = xin[(size_t)b * xs + k]; sq = fmaf(xv, xv, sq); }
#pragma unroll
                for (int o = 1; o < 64; o <<= 1) sq += __shfl_xor(sq, o);
                v *= rsqrtf(sq * (1.f / D) + EPS); }
            const int n = n0 + lane;
            if (kind == SK_PROJ) SD[SD_PRJ + b * 6144 + n] = v;
            else if (kind == SK_W1) { const float r = fmaxf(v, 0.f); SD[SD_HS + b * FF + n] = r * r; }
            else if (kind == SK_UP) SD[SD_US + b * D + n] = v;
            else { const float xo = XSc[b * D + n]; const float xn = (kind == SK_GATE) ? fmaf(sigmoidf_(v), SD[SD_US + b * D + n], xo) : xo + v;
                XSn[b * D + n] = xn; const size_t row = (size_t)b * SEQ; a->out[row * D + n] = xn;
                bf16_t* XBw = (kind == SK_W2) ? ((bf16_t*)(a->ws + WS_T) + (size_t)5 * 32 * MiB) : (bf16_t*)(a->ws + WS_XB);
                XBw[row * D + n] = (bf16_t)(pk2(xn, 0.f) & 0xffffu);
                float ss = xn * xn;
#pragma unroll
                for (int o = 1; o < 64; o <<= 1) ss += __shfl_xor(ss, o);
                if (lane == 0) ((float*)(a->ws + (sv ? WS_SSP0 : WS_SSP1)))[row * 16 + it] = ss; }
        }
        __syncthreads();
    }
}
__device__ __forceinline__ void side_mixer(int i, float lam, int G) {
    KArgs a = kargs(); const int tid = opaque_tid(), lane = tid & 63, wave = __builtin_amdgcn_readfirstlane(tid >> 6), gw = opaque_bid() * NWAVES + wave;
    float* SD = (float*)(a->ws + WS_SIDE); const int j = i >> 1;
    if ((i & 1) == 0) { if (gw < NBATCH * 8) { const int b = gw >> 3, h = gw & 7; const float* vp = SD + SD_PRJ + b * 6144 + h * 128;
            const float o0 = (1.f - lam) * vp[lane], o1 = (1.f - lam) * vp[64 + lane]; float ss = o0 * o0 + o1 * o1;
#pragma unroll
            for (int o = 1; o < 64; o <<= 1) ss += __shfl_xor(ss, o);
            const float rn = rsqrtf(ss * (1.f / 128.f) + EPS) * (1.f - lambda_init_of(i)); const float* g = a->a_g_sub + j * 128;
            SD[SD_AV + b * 2048 + h * 128 + lane] = o0 * rn * g[lane]; SD[SD_AV + b * 2048 + h * 128 + 64 + lane] = o1 * rn * g[64 + lane]; } }
    else { if (gw < NBATCH * 4) { const int b = gw >> 2, h = gw & 3; const float* pp = SD + SD_PRJ + b * 6144; float w = 0.f;
#pragma unroll
            for (int t = 0; t < 4; ++t) w = fmaf(pp[h * 256 + 64 * t + lane], pp[1024 + h * 256 + 64 * t + lane], w);
#pragma unroll
            for (int o = 1; o < 64; o <<= 1) w += __shfl_xor(w, o);
            w *= 0.0625f; float ov[8]; float ss = 0.f;
#pragma unroll
            for (int t = 0; t < 8; ++t) { ov[t] = w * pp[2048 + h * 512 + 64 * t + lane]; ss = fmaf(ov[t], ov[t], ss); }
#pragma unroll
            for (int o = 1; o < 64; o <<= 1) ss += __shfl_xor(ss, o);
            const float rn = rsqrtf(ss * (1.f / 512.f) + EPS); const float* g = a->r_g_gn + j * 512;
#pragma unroll
            for (int t = 0; t < 8; ++t) { const float gt = pp[4096 + h * 512 + 64 * t + lane]; SD[SD_AV + b * 2048 + h * 512 + 64 * t + lane] = gt * sigmoidf_(gt) * ov[t] * rn * g[64 * t + lane]; } } }
}

#define GSYNC() do { asm volatile("s_waitcnt vmcnt(0) lgkmcnt(0)" ::: "memory"); __builtin_amdgcn_fence(__ATOMIC_RELEASE, "agent"); asm volatile("s_waitcnt vmcnt(0)" ::: "memory"); \
    grid.sync(); __builtin_amdgcn_fence(__ATOMIC_ACQUIRE, "agent"); asm volatile("s_waitcnt vmcnt(0)" ::: "memory"); } while (0)
__global__ void __launch_bounds__(NWAVES * 64, 2) fwd_mega(Args a) {
    extern __shared__ __attribute__((aligned(16))) unsigned char lds_raw[];
    cg::grid_group grid = cg::this_grid();
    LAS unsigned char* lds = (LAS unsigned char*)lds_raw;
    const int G = gridDim.x;
    unsigned char* ws = kargs()->ws;
    bf16_t* XB = (bf16_t*)(ws + WS_XB); bf16_t* PB = (bf16_t*)(ws + WS_PB);
    bf16_t* T0 = (bf16_t*)(ws + WS_T);
    bf16_t* W_IN = (bf16_t*)(ws + WS_WIN); bf16_t* W_OUT = (bf16_t*)(ws + WS_WOUT); bf16_t* W_1 = (bf16_t*)(ws + WS_W1); bf16_t* W_2 = (bf16_t*)(ws + WS_W2);
    bf16_t* W_UP = (bf16_t*)(ws + WS_WUP); bf16_t* W_GATE = (bf16_t*)(ws + WS_WGATE);
    float* SSO = (float*)(ws + WS_SSO);
    const size_t E64 = (size_t)32 * MiB;

    prologue_rows(G);
    convert_in(0, lds, G);
    GSYNC();

    int sv = 0;
    for (int i = 0; i < 4; ++i) {
        const bool attn = (i & 1) == 0; const int j = i >> 1;
        for (int slot = 0; slot < 11; ++slot) {
            int sk = -1;
            int kind = 0;
            bool sync = false, flip = false;
            const bf16_t* gA = nullptr; const bf16_t* gB = nullptr; int gM = 0, gN = 0, gK = 0;
            EpiG E; E.mode = 0; E.layer = i; E.sv = sv; E.xbalt = 0; E.ret = 0; E.ws = ws;
            if (slot == 0) { kind = 4; }
            else if (slot == 1) { kind = 1; sk = SK_PROJ; gA = XB; gB = W_IN; gM = M; gK = D;
                if (attn) { gN = 2048; E.mode = MODE_ATTN_QK; } else { gN = 4096; E.mode = MODE_RET_QKG; } }
            else if (slot == 2) { kind = 1; sync = true; gB = XB; gN = M; gK = D; E.mode = MODE_VT;
                if (attn) { gA = W_IN + (size_t)2048 * D; gM = 1024; } else { gA = W_IN + (size_t)4096 * D; gM = 2048; E.ret = 1; } }
            else if (slot == 3) { kind = 2; sync = true; }
            else if (slot == 4) { if (!attn) { kind = 3; sync = true; } }
            else if (slot == 5) { kind = 1; sk = SK_OUT; sync = true; flip = true; gB = W_OUT; gM = M; gN = D; E.mode = MODE_RESID;
                if (attn) { gA = T0 + 3 * E64; gK = 1024; } else { gA = T0 + 4 * E64; gK = 2048; } }
            else if (slot == 6) { kind = 1; sk = SK_W1; gA = XB; gB = W_1; gM = M; gN = FF; gK = D; E.mode = MODE_SQRELU; }
            else if (slot == 7) { kind = 1; sk = SK_UP; sync = true; gA = PB; gB = W_UP; gM = M; gN = D; gK = PLE; E.mode = MODE_PLAIN; }
            else if (slot == 8) { kind = 1; sk = SK_W2; sync = true; flip = true; gA = T0; gB = W_2; gM = M; gN = D; gK = FF; E.mode = MODE_RESID; E.xbalt = 1; }
            else if (slot == 9) { if (i < 3) kind = 5; }
            else { kind = 1; sk = SK_GATE; sync = (i < 3); flip = true; gA = T0 + 5 * E64; gB = W_GATE; gM = M; gN = D; gK = D; E.mode = MODE_GATE; }

            if (kind == 1) {
                __syncthreads();
                if (sk >= 0) side_step(sk, i, sv, lds, G);
                __syncthreads();
                pg8::Gemm g{gA, gB, gM, gN, gK}; pg8::StaticOrder S; S.init(gM, gN, G, opaque_bid());
#ifndef NO_GEMM
                pg8::gemm_phase<EpiG, pg8::StaticOrder, GEMM_ALIGN, GEMM_SP2>(lds, g, S, E);
#endif
            } else if (kind == 2) {
                __syncthreads();
                if (attn) {
                    const int lane = opaque_tid() & 63;
                    KArgs ka = kargs();
                    float d1 = ka->a_lq1[j * 64 + lane] * ka->a_lk1[j * 64 + lane], d2 = ka->a_lq2[j * 64 + lane] * ka->a_lk2[j * 64 + lane];
#pragma unroll
                    for (int o = 1; o < 64; o <<= 1) { d1 += __shfl_xor(d1, o); d2 += __shfl_xor(d2, o); }
                    const float lam = expf(d1) - expf(d2) + lambda_init_of(i);
                    side_mixer(i, lam, G);
#if defined(NAIVE_ATTN)
                    attn_naive(T0, T0 + E64, T0 + 2 * E64, T0 + 3 * E64, lam, G);
#elif !defined(NO_ATTN)
                    attn_phase(lds, T0, T0 + E64, T0 + 2 * E64, T0 + 3 * E64, lam, G);
#endif
                } else {
                    side_mixer(i, 0.f, G);
#if defined(NAIVE_RET)
                    ret_naive(T0, T0 + E64, T0 + 2 * E64, T0 + 4 * E64, SSO, G);
#elif !defined(NO_RET)
                    ret_phase(lds, T0, T0 + E64, T0 + 2 * E64, T0 + 4 * E64, SSO, G);
#endif
                }
            } else if (kind == 3) {
                ret_norm_phase(T0 + 4 * E64, SSO, G);
            } else if (kind == 4) {
                __syncthreads();
                convert_rest(i, lds, G);
            } else if (kind == 5) {
                __syncthreads();
                convert_in(i + 1, lds, G);
            }
            if (flip) sv ^= 1;
            if (sync) GSYNC();
        }
    }
}

extern "C" void kernel_launch(void* const* d_in, const int* in_sizes, int n_in, void* d_out, int out_size, void* d_ws, size_t ws_size, hipStream_t stream) {
    static int grid = 0;
    if (grid == 0) {
        if (n_in != 21 || out_size != M * D || ws_size < WS_END) { fprintf(stderr, "kernel_launch: unexpected shapes (n_in %d, out %d, ws %zu)\n", n_in, out_size, ws_size); grid = -1; return; }
        int dev = 0, cus = 0, per_cu = 0;
        hipGetDevice(&dev); hipDeviceGetAttribute(&cus, hipDeviceAttributeMultiprocessorCount, dev);
        hipFuncSetAttribute((const void*)fwd_mega, hipFuncAttributeMaxDynamicSharedMemorySize, LDS_BYTES);
        hipOccupancyMaxActiveBlocksPerMultiprocessor(&per_cu, (const void*)fwd_mega, NWAVES * 64, LDS_BYTES);
        if (per_cu < 1) per_cu = 1;
        grid = cus * per_cu;
        if (grid > 256) grid = 256;
        (void)hipGetLastError();
    }
    if (grid < 0) return;
    Args a{};
    a.x = (const float*)d_in[0]; a.p = (const float*)d_in[1]; a.norm_mix = (const float*)d_in[2]; a.norm_mlp = (const float*)d_in[3]; a.norm_pe = (const float*)d_in[4];
    a.a_w_qkv = (const float*)d_in[5]; a.a_w_o = (const float*)d_in[6]; a.a_g_q = (const float*)d_in[7]; a.a_g_k = (const float*)d_in[8];
    a.a_lq1 = (const float*)d_in[9]; a.a_lk1 = (const float*)d_in[10]; a.a_lq2 = (const float*)d_in[11]; a.a_lk2 = (const float*)d_in[12]; a.a_g_sub = (const float*)d_in[13];
    a.r_w_in = (const float*)d_in[14]; a.r_w_out = (const float*)d_in[15]; a.r_g_gn = (const float*)d_in[16]; a.mlp_w1 = (const float*)d_in[17]; a.mlp_w2 = (const float*)d_in[18];
    a.pe_w_up = (const float*)d_in[19]; a.pe_w_gate = (const float*)d_in[20];
    a.out = (float*)d_out; a.ws = (unsigned char*)d_ws;
    void* args[] = {&a};
    hipError_t e = hipLaunchCooperativeKernel((const void*)fwd_mega, dim3(grid), dim3(NWAVES * 64), args, LDS_BYTES, stream);
    if (e != hipSuccess) fprintf(stderr, "cooperative launch failed: %s (grid %d)\n", hipGetErrorString(e), grid);
}
```

```cpp
#include <hip/hip_runtime.h>
#include <hip/hip_cooperative_groups.h>
#include <cstdio>
#include <cstdint>
namespace cg = cooperative_groups;
#ifndef GEMM_ALIGN
#define GEMM_ALIGN true
#define GEMM_SP2 false
#endif
namespace pg8 {
#define PG8_LAS __attribute__((address_space(3)))
typedef unsigned short bf16_t;
typedef short bf16x8 __attribute__((ext_vector_type(8)));
typedef float f32x4 __attribute__((ext_vector_type(4)));
typedef unsigned u32x4 __attribute__((ext_vector_type(4)));
constexpr int BM = 256, BK = 64, HALF = 128, HTB = HALF * BK * 2  , STAGE_BYTES = 8 * HTB, NXCD = 8, WGM = 8;

__host__ __device__ __forceinline__ int lds_byte(int r, int c) { const int st = (r >> 4) * 2 + (c >> 5), rr = r & 15, cc = c & 31, ob = rr * 64 + cc * 2; return st * 1024 + (ob ^ (((ob >> 9) & 1) << 5)); }
__host__ __device__ __forceinline__ void stage_rc(int b, int& R, int& C) { const int st = b / 1024, sb = b % 1024, swz = sb ^ (((sb >> 9) & 1) << 5); R = (st >> 1) * 16 + swz / 64; C = (st & 1) * 32 + (swz % 64) / 2; }
__host__ __device__ __forceinline__ int perm32(int rho) { const int n = rho >> 4, i = rho & 15; return 8 * (i >> 2) + 4 * n + (i & 3); }

struct Unit { int pm, pn; };
struct Gemm { const bf16_t* A; const bf16_t* Bt; int M, N, K; };

struct StaticOrder {
    int nM, nN, nwg, G, c;
    __host__ __device__ void init(int M, int N, int G_, int c_) { nM = M / BM; nN = N / BM; nwg = nM * nN; G = G_; c = c_; }
    __host__ __device__ bool next(int i, Unit& u) const {
        const long L = (long)i * G + c; if (L >= nwg) return false;
        int wgid = (int)L; { const int q = nwg / NXCD, r = nwg % NXCD, xcd = wgid % NXCD, off = wgid / NXCD; wgid = (xcd < r ? xcd * (q + 1) : r * (q + 1) + (xcd - r) * q) + off; }
        const int nig = WGM * nN, gid = wgid / nig, fm = gid * WGM, gsz = (nM - fm) < WGM ? (nM - fm) : WGM;
        u.pm = fm + ((wgid % nig) % gsz); u.pn = (wgid % nig) / gsz; return true;
    }
    __device__ __forceinline__ void a_ready(const Unit&) const {}
    __device__ __forceinline__ void done(const Unit&) const {}
};

__device__ __forceinline__ unsigned cvt_pk_bf16(float lo, float hi) { unsigned r; asm volatile("v_cvt_pk_bf16_f32 %0, %1, %2" : "=v"(r) : "v"(lo), "v"(hi)); return r; }
typedef float f32x2 __attribute__((ext_vector_type(2)));
template <class Epi, class Sched, bool ALIGN_EPI = false, bool SP2 = false>
__device__ __forceinline__ void gemm_phase(PG8_LAS unsigned char* lds, const Gemm g, const Sched& S, const Epi& E) {
    int tid = threadIdx.x; asm volatile("" : "+v"(tid)); const int wid = __builtin_amdgcn_readfirstlane(tid >> 6), lane = tid & 63, wr = wid >> 2, wc = wid & 3, fr = lane & 15, fq = lane >> 4;
    const int K = g.K, nt = K / BK;
    unsigned voffA, voffB;
    { int R, C; stage_rc(tid * 16, R, C); const int Rb = Epi::PERM ? ((R & ~31) + perm32(R & 31)) : R;
        voffA = (unsigned)(R * K + C) * 2u; voffB = (unsigned)(Rb * K + C) * 2u; }
    const size_t pstep = (size_t)128 * K;
    const size_t kstep = (size_t)(BK * 2);
    const size_t hstep = (size_t)HALF * K * 2;
    const size_t tstep = 2 * hstep;
    const unsigned ldsw = (unsigned)wid * 1024u;
    const int aoff = lds_byte(wr * 64 + fr, fq * 8), boff = lds_byte(wc * 32 + fr, fq * 8);
#define PG8_SA(b, h) (((b) * 2 + (h)) * HTB)
#define PG8_SB(b, h) ((4 + (b) * 2 + (h)) * HTB)
#define PG8_STAGE(bufoff, gbase, voff) do { _Pragma("unroll") for (int _i = 0; _i < 2; ++_i) \
        __builtin_amdgcn_global_load_lds((const unsigned*)((const char*)(gbase) + _i * pstep + (voff)), (PG8_LAS unsigned*)(lds + (bufoff) + ldsw + _i * 8192), 16, 0, 0); } while (0)
#define PG8_LDA(dst, b, h) do { _Pragma("unroll") for (int m = 0; m < 4; ++m) _Pragma("unroll") for (int k = 0; k < 2; ++k) dst[m][k] = *(const PG8_LAS bf16x8*)(lds + PG8_SA(b, h) + aoff + m * 2048 + k * 1024); } while (0)
#define PG8_LDB(dst, b, h) do { _Pragma("unroll") for (int n = 0; n < 2; ++n) _Pragma("unroll") for (int k = 0; k < 2; ++k) dst[n][k] = *(const PG8_LAS bf16x8*)(lds + PG8_SB(b, h) + boff + n * 2048 + k * 1024); } while (0)
#define PG8_MMA(ai, bj, At, Bt) do { __builtin_amdgcn_s_setprio(1); _Pragma("unroll") for (int m = 0; m < 4; ++m) _Pragma("unroll") for (int n = 0; n < 2; ++n) _Pragma("unroll") for (int k = 0; k < 2; ++k) \
        acc[ai][bj][m][n] = __builtin_amdgcn_mfma_f32_16x16x32_bf16(Bt[n][k], At[m][k], acc[ai][bj][m][n], 0, 0, 0); __builtin_amdgcn_s_setprio(0); } while (0)
#define PG8_WAIT_V(n) asm volatile("s_waitcnt vmcnt(" #n ")" ::: "memory")
#define PG8_WAIT_L(n) asm volatile("s_waitcnt lgkmcnt(" #n ")" ::: "memory")
#define PG8_BAR __builtin_amdgcn_s_barrier()
#define PG8_SCHED __builtin_amdgcn_sched_barrier(0)
    Unit cur, nxt; int ui = 0;
    if (!S.next(0, cur)) return;
    f32x4 acc[2][2][4][2];
#pragma unroll
    for (int a = 0; a < 2; ++a)
#pragma unroll
        for (int b = 0; b < 2; ++b)
#pragma unroll
            for (int m = 0; m < 4; ++m)
#pragma unroll
                for (int n = 0; n < 2; ++n) acc[a][b][m][n] = (f32x4){0.f, 0.f, 0.f, 0.f};
    bf16x8 At[4][2], B0[2][2], B1[2][2];
    const char* cA = (const char*)g.A + (size_t)cur.pm * tstep; const char* cB = (const char*)g.Bt + (size_t)cur.pn * tstep;
    S.a_ready(cur);
    if constexpr (SP2) {
        PG8_STAGE(PG8_SB(0, 0), cB, voffB); PG8_STAGE(PG8_SB(0, 1), cB + hstep, voffB); PG8_STAGE(PG8_SA(0, 0), cA, voffA); PG8_STAGE(PG8_SA(0, 1), cA + hstep, voffA);
        if (wr == 1) PG8_BAR;
        PG8_WAIT_V(2); PG8_BAR;
        PG8_STAGE(PG8_SB(1, 0), cB + kstep, voffB); PG8_STAGE(PG8_SA(1, 0), cA + kstep, voffA); PG8_STAGE(PG8_SB(1, 1), cB + hstep + kstep, voffB);
        PG8_WAIT_V(6); PG8_BAR;
    } else {
        PG8_STAGE(PG8_SB(0, 0), cB, voffB); PG8_STAGE(PG8_SA(0, 0), cA, voffA); PG8_STAGE(PG8_SB(0, 1), cB + hstep, voffB); PG8_STAGE(PG8_SA(0, 1), cA + hstep, voffA);
        if (wr == 1) PG8_BAR;
        PG8_WAIT_V(4); PG8_BAR;
        PG8_STAGE(PG8_SB(1, 0), cB + kstep, voffB); PG8_STAGE(PG8_SA(1, 0), cA + kstep, voffA); PG8_STAGE(PG8_SB(1, 1), cB + hstep + kstep, voffB);
        PG8_WAIT_V(6); PG8_BAR;
    }
    for (;;) {
        const bool has_next = S.next(ui + 1, nxt);
        const char* nA = has_next ? (const char*)g.A + (size_t)nxt.pm * tstep : cA; const char* nB = has_next ? (const char*)g.Bt + (size_t)nxt.pn * tstep : cB;
        for (int t = 0; t < nt; t += 2) {
            const bool last = (t == nt - 2);
            const char* a1 = cA + (size_t)(t + 1) * kstep;
            const char* a2 = last ? nA : cA + (size_t)(t + 2) * kstep; const char* b2 = last ? nB : cB + (size_t)(t + 2) * kstep;
            const char* a3 = a2 + kstep; const char* b3 = b2 + kstep;
            if (last && has_next) S.a_ready(nxt);
            if constexpr (SP2) {
            PG8_LDB(B0, 0, 0); PG8_LDB(B1, 0, 1); PG8_SCHED; PG8_LDA(At, 0, 0); PG8_STAGE(PG8_SA(1, 1), a1 + hstep, voffA);
            PG8_WAIT_V(8); PG8_WAIT_L(0); PG8_BAR; PG8_MMA(0, 0, At, B0); PG8_MMA(0, 1, At, B1); PG8_BAR; PG8_SCHED;
            PG8_LDA(At, 0, 1); PG8_STAGE(PG8_SB(0, 0), b2, voffB); PG8_STAGE(PG8_SB(0, 1), b2 + hstep, voffB); PG8_STAGE(PG8_SA(0, 0), a2, voffA);
            PG8_WAIT_V(8); PG8_WAIT_L(0); PG8_BAR; PG8_MMA(1, 0, At, B0); PG8_MMA(1, 1, At, B1); PG8_BAR; PG8_SCHED;
            PG8_LDB(B0, 1, 0); PG8_LDB(B1, 1, 1); PG8_SCHED; PG8_LDA(At, 1, 0); PG8_STAGE(PG8_SA(0, 1), a2 + hstep, voffA);
            PG8_WAIT_V(8); PG8_WAIT_L(0); PG8_BAR; PG8_MMA(0, 0, At, B0); PG8_MMA(0, 1, At, B1); PG8_BAR; PG8_SCHED;
            PG8_LDA(At, 1, 1); PG8_STAGE(PG8_SB(1, 0), b3, voffB); PG8_STAGE(PG8_SB(1, 1), b3 + hstep, voffB); PG8_STAGE(PG8_SA(1, 0), a3, voffA);
            PG8_WAIT_V(8); PG8_WAIT_L(0); PG8_BAR; PG8_MMA(1, 0, At, B0); PG8_MMA(1, 1, At, B1); PG8_BAR; PG8_SCHED;
            } else {
            PG8_LDB(B0, 0, 0); PG8_SCHED; PG8_LDA(At, 0, 0); PG8_STAGE(PG8_SA(1, 1), a1 + hstep, voffA);
            PG8_WAIT_L(8); PG8_BAR; PG8_WAIT_L(0); PG8_MMA(0, 0, At, B0); PG8_BAR; PG8_SCHED;
            PG8_LDB(B1, 0, 1); PG8_STAGE(PG8_SB(0, 0), b2, voffB);
            PG8_BAR; PG8_WAIT_L(0); PG8_MMA(0, 1, At, B1); PG8_BAR;
            PG8_LDA(At, 0, 1); PG8_STAGE(PG8_SA(0, 0), a2, voffA);
            PG8_BAR; PG8_WAIT_L(0); PG8_MMA(1, 0, At, B0); PG8_BAR; PG8_SCHED;
            PG8_STAGE(PG8_SB(0, 1), b2 + hstep, voffB);
            PG8_WAIT_V(6); PG8_BAR; PG8_MMA(1, 1, At, B1); PG8_BAR;
            PG8_LDB(B0, 1, 0); PG8_SCHED; PG8_LDA(At, 1, 0); PG8_STAGE(PG8_SA(0, 1), a2 + hstep, voffA);
            PG8_WAIT_L(8); PG8_BAR; PG8_WAIT_L(0); PG8_MMA(0, 0, At, B0); PG8_BAR; PG8_SCHED;
            PG8_LDB(B1, 1, 1); PG8_STAGE(PG8_SB(1, 0), b3, voffB);
            PG8_BAR; PG8_WAIT_L(0); PG8_MMA(0, 1, At, B1); PG8_BAR;
            PG8_LDA(At, 1, 1); PG8_STAGE(PG8_SA(1, 0), a3, voffA);
            PG8_BAR; PG8_WAIT_L(0); PG8_MMA(1, 0, At, B0); PG8_BAR; PG8_SCHED;
            PG8_STAGE(PG8_SB(1, 1), b3 + hstep, voffB);
            PG8_WAIT_V(6); PG8_BAR; PG8_MMA(1, 1, At, B1); PG8_BAR;
            }
        }
        if constexpr (ALIGN_EPI) { if (wr == 0) PG8_BAR; }
        if constexpr (!Epi::AFTER_DRAIN) { E(acc, cur, wr, wc, fr, fq); S.done(cur); }
        if (!has_next) break;
#pragma unroll
        for (int a = 0; a < 2; ++a)
#pragma unroll
            for (int b = 0; b < 2; ++b)
#pragma unroll
                for (int m = 0; m < 4; ++m)
#pragma unroll
                    for (int n = 0; n < 2; ++n) acc[a][b][m][n] = (f32x4){0.f, 0.f, 0.f, 0.f};
        cur = nxt; cA = nA; cB = nB; ++ui;
        if constexpr (ALIGN_EPI) { if (wr == 1) PG8_BAR; }
    }
    PG8_WAIT_V(0);
    if constexpr (!ALIGN_EPI) { if (wr == 0) PG8_BAR; }
    PG8_BAR;
    if constexpr (Epi::AFTER_DRAIN) { E.fused(acc, cur, wr, wc, fr, fq, lds, wid, lane); S.done(cur); }
#undef PG8_SA
#undef PG8_SB
#undef PG8_STAGE
#undef PG8_LDA
#undef PG8_LDB
#undef PG8_MMA
#undef PG8_WAIT_V
#undef PG8_WAIT_L
#undef PG8_BAR
#undef PG8_SCHED
}
}

using pg8::bf16_t; using pg8::bf16x8; using pg8::f32x4; using pg8::u32x4;
typedef float f32x16 __attribute__((ext_vector_type(16)));
typedef unsigned u32x2 __attribute__((ext_vector_type(2)));
typedef short s16x4 __attribute__((ext_vector_type(4)));
#define LAS __attribute__((address_space(3)))
constexpr int D = 1024, NBATCH = 16, SEQ = 2048, M = NBATCH * SEQ, FF = 4096, PLE = 256, NWAVES = 8;
constexpr float EPS = 1e-6f, LOG2E = 1.4426950408889634f;
constexpr size_t MiB = 1u << 20;
constexpr size_t WS_SSP0 = 0, WS_SSO = 2 * MiB, WS_WIN = 10 * MiB, WS_WOUT = 22 * MiB, WS_W1 = 26 * MiB, WS_W2 = 34 * MiB, WS_WUP = 42 * MiB, WS_WGATE = 42 * MiB + 512 * 1024,
                 WS_QK0 = 44 * MiB + 512 * 1024, WS_XB = 45 * MiB, WS_PB = 109 * MiB, WS_T = 125 * MiB, WS_SSP1 = 509 * MiB, WS_SIDE = 511 * MiB, WS_END = 512 * MiB;
constexpr int SD_XS = 0, SD_PRJ = 32768, SD_AV = 131072, SD_HS = 163840, SD_US = 229376;
constexpr int LDS_BYTES = 147456;

__device__ __forceinline__ int opaque_tid() { int t = threadIdx.x; asm volatile("" : "+v"(t)); return t; }
__device__ __forceinline__ int opaque_bid() { int t = blockIdx.x; asm volatile("" : "+s"(t)); return t; }
typedef float f32x2_t __attribute__((ext_vector_type(2))); typedef __bf16 bf16x2_t __attribute__((ext_vector_type(2)));
__device__ __forceinline__ unsigned pk2(float lo, float hi) { f32x2_t v = {lo, hi}; bf16x2_t b = __builtin_convertvector(v, bf16x2_t); return __builtin_bit_cast(unsigned, b); }
__device__ __forceinline__ float bf_lo(unsigned w) { return __uint_as_float(w << 16); }
__device__ __forceinline__ float bf_hi(unsigned w) { return __uint_as_float(w & 0xffff0000u); }
__device__ __forceinline__ float fexp2(float x) { return __builtin_amdgcn_exp2f(x); }
__device__ __forceinline__ float sigmoidf_(float z) { return __builtin_amdgcn_rcpf(1.f + fexp2(-z * LOG2E)); }
__device__ __forceinline__ float dot4(f32x4 v) { return (v.x * v.x + v.y * v.y) + (v.z * v.z + v.w * v.w); }
__device__ __forceinline__ float sum4(f32x4 v) { return (v.x + v.y) + (v.z + v.w); }
__device__ __forceinline__ u32x4 pack8(f32x4 a, f32x4 b) { u32x4 w; w.x = pk2(a.x, a.y); w.y = pk2(a.z, a.w); w.z = pk2(b.x, b.y); w.w = pk2(b.z, b.w); return w; }

struct Args {
    const float *x, *p, *norm_mix, *norm_mlp, *norm_pe, *a_w_qkv, *a_w_o, *a_g_q, *a_g_k, *a_lq1, *a_lk1, *a_lq2, *a_lk2, *a_g_sub, *r_w_in, *r_w_out, *r_g_gn, *mlp_w1, *mlp_w2, *pe_w_up, *pe_w_gate;
    float* out; unsigned char* ws;
};

typedef const __attribute__((address_space(4))) Args* KArgs;
__device__ __forceinline__ KArgs kargs() { KArgs p = (KArgs)__builtin_amdgcn_kernarg_segment_ptr(); asm volatile("" : "+s"(p)); return p; }
enum { MODE_PLAIN = 0, MODE_ATTN_QK = 1, MODE_RET_QKG = 2, MODE_SQRELU = 3, MODE_RESID = 4, MODE_GATE = 5, MODE_VT = 6 };
struct EpiG {
    static constexpr bool PERM = true, AFTER_DRAIN = false;
    int mode, layer, sv, xbalt, ret, x0src, nobf;
    int pad2_;
    unsigned char* ws;
    __device__ __forceinline__ void operator()(const f32x4 (&acc)[2][2][4][2], const pg8::Unit& u, int wr_, int wc_, int fr_, int fq_) const {
        const int t2 = opaque_tid(); const int lane = t2 & 63, fr = lane & 15, fq = lane >> 4, wv_ = __builtin_amdgcn_readfirstlane(t2 >> 6), wr = wv_ >> 2, wc = wv_ & 3;
        (void)wr_; (void)wc_; (void)fr_; (void)fq_;
        const float* ssp = (const float*)(ws + (sv ? WS_SSP1 : WS_SSP0)); float* sspw = (float*)(ws + (sv ? WS_SSP0 : WS_SSP1));
        bf16_t* T0 = (bf16_t*)(ws + WS_T); const size_t E64 = (size_t)32 * MiB;
        bf16_t* o0 = T0; bf16_t* o1 = T0 + E64; bf16_t* o2 = T0 + 4 * E64; int ld0 = D;
        if (mode == MODE_VT) { o0 = T0 + 2 * E64; ld0 = M; } else if (mode == MODE_SQRELU) { ld0 = FF; } else if (mode == MODE_PLAIN) { o0 = T0 + 4 * E64; }
        if (mode == MODE_VT) {
            const int tokL = u.pn * 256 + (lane >> 5) * 128 + wc * 32 + (lane & 31);
            const f32x4* sp = (const f32x4*)(ssp + (size_t)tokL * 16);
            const f32x4 a = sp[0], b = sp[1], c = sp[2], d = sp[3];
            const float s = (sum4(a) + sum4(b)) + (sum4(c) + sum4(d));
            const float rsL = rsqrtf(s * (1.f / 1024.f) + EPS);
            float l2g = 0.f; if (ret) { const int h = u.pm >> 1; l2g = log2f(1.f - fexp2(-5.f - (float)h)); }
#pragma unroll
            for (int bj = 0; bj < 2; ++bj) {
                bf16_t* vbase = T0 + 2 * E64 + (size_t)(u.pm * 256 + wr * 64 + fr) * M + u.pn * 256 + wc * 32 + 8 * fq + bj * 128;
                f32x4 cs[2];
#pragma unroll
                for (int n = 0; n < 2; ++n)
#pragma unroll
                    for (int x = 0; x < 4; ++x) { float v = __shfl(rsL, 32 * bj + 8 * fq + 4 * n + x); if (ret) v *= fexp2(l2g * (float)(127 - (32 * wc + 8 * fq + 4 * n + x))); cs[n][x] = v; }
#pragma unroll
                for (int ai = 0; ai < 2; ++ai)
#pragma unroll
                    for (int m = 0; m < 4; ++m) { bf16_t* rowp = vbase + (size_t)(ai * 128 + m * 16) * M;
                        *(u32x4*)(rowp) = pack8(acc[ai][bj][m][0] * cs[0], acc[ai][bj][m][1] * cs[1]); }
                asm volatile("" ::: "memory");
            }
            return;
        }
        const int row0 = u.pm * 256 + wr * 64 + fr;
        float rs[2][4];
        if (mode != MODE_PLAIN && mode != MODE_RESID) {
            f32x4 sv4[2][4];
#pragma unroll
            for (int ai = 0; ai < 2; ++ai)
#pragma unroll
                for (int m = 0; m < 4; ++m) sv4[ai][m] = *(const f32x4*)(ssp + (size_t)(row0 + ai * 128 + m * 16) * 16 + 4 * fq);
            __builtin_amdgcn_sched_barrier(0);
#pragma unroll
            for (int ai = 0; ai < 2; ++ai)
#pragma unroll
                for (int m = 0; m < 4; ++m) { float s = sum4(sv4[ai][m]); s += __shfl_xor(s, 16); s += __shfl_xor(s, 32); rs[ai][m] = rsqrtf(s * (1.f / 1024.f) + EPS); }
        } else {
#pragma unroll
            for (int ai = 0; ai < 2; ++ai)
#pragma unroll
                for (int m = 0; m < 4; ++m) rs[ai][m] = 1.f;
        }
        if (mode == MODE_RESID || mode == MODE_GATE) {
            float* X = kargs()->out; const float* Xr = x0src ? kargs()->x : (const float*)X; const bf16_t* U = T0 + 4 * E64; bf16_t* XBw = xbalt ? (T0 + 5 * E64) : (bf16_t*)(ws + WS_XB);
#pragma unroll
            for (int am = 0; am < 4; ++am) { const int ai = am >> 1, m0 = (am & 1) * 2;
                f32x4 xa[4][2][2]; u32x4 ua[4][2];
#pragma unroll
                for (int m = m0; m < m0 + 2; ++m)
#pragma unroll
                    for (int bj = 0; bj < 2; ++bj) { const int row = row0 + ai * 128 + m * 16, col0 = u.pn * 256 + bj * 128 + wc * 32 + 8 * fq; const float* xp = Xr + (size_t)row * D + col0;
                        xa[m][bj][0] = *(const f32x4*)xp; xa[m][bj][1] = *(const f32x4*)(xp + 4);
                        if (mode == MODE_GATE) ua[m][bj] = *(const u32x4*)(U + (size_t)row * D + col0); else ua[m][bj] = (u32x4){0u, 0u, 0u, 0u}; }
                __builtin_amdgcn_sched_barrier(0);
#pragma unroll
                for (int m = m0; m < m0 + 2; ++m) { const int row = row0 + ai * 128 + m * 16; float ss = 0.f; const float r = rs[ai][m]; const bool skip = (row & (SEQ - 1)) == 0;
#pragma unroll
                    for (int bj = 0; bj < 2; ++bj) { const int col0 = u.pn * 256 + bj * 128 + wc * 32 + 8 * fq; float* xp = X + (size_t)row * D + col0;
                        f32x4 x0 = xa[m][bj][0], x1 = xa[m][bj][1]; f32x4 v0 = acc[ai][bj][m][0], v1 = acc[ai][bj][m][1];
                        if (mode == MODE_GATE) { const u32x4 uw = ua[m][bj];
                            v0.x = sigmoidf_(v0.x * r) * bf_lo(uw.x); v0.y = sigmoidf_(v0.y * r) * bf_hi(uw.x); v0.z = sigmoidf_(v0.z * r) * bf_lo(uw.y); v0.w = sigmoidf_(v0.w * r) * bf_hi(uw.y);
                            v1.x = sigmoidf_(v1.x * r) * bf_lo(uw.z); v1.y = sigmoidf_(v1.y * r) * bf_hi(uw.z); v1.z = sigmoidf_(v1.z * r) * bf_lo(uw.w); v1.w = sigmoidf_(v1.w * r) * bf_hi(uw.w); }
                        x0 += v0; x1 += v1; ss += dot4(x0) + dot4(x1);
                        if (!skip) { *(f32x4*)xp = x0; *(f32x4*)(xp + 4) = x1; if (!nobf) *(u32x4*)(XBw + (size_t)row * D + col0) = pack8(x0, x1); } }
                    ss += __shfl_xor(ss, 16); ss += __shfl_xor(ss, 32);
                    if (fq == 0 && !skip) sspw[(size_t)row * 16 + u.pn * 4 + wc] = ss; }
            }
            return;
        }
        if (mode == MODE_ATTN_QK) {
            const bool isq = u.pn < 4; const float* g = (isq ? kargs()->a_g_q : kargs()->a_g_k) + (layer >> 1) * 64; const float sc = isq ? 0.125f * LOG2E : 1.f;
            bf16_t* base = (isq ? o0 : o1) + (u.pn & 3) * 256 + wc * 64 + 8 * fq;
            f32x4 gv[2][2];
#pragma unroll
            for (int bj = 0; bj < 2; ++bj)
#pragma unroll
                for (int n = 0; n < 2; ++n) gv[bj][n] = *(const f32x4*)(g + 32 * bj + 8 * fq + 4 * n);
#pragma unroll
            for (int ai = 0; ai < 2; ++ai)
#pragma unroll
                for (int m = 0; m < 4; ++m) { const int row = row0 + ai * 128 + m * 16; const float r = rs[ai][m]; f32x4 v[2][2]; float ss = 0.f;
#pragma unroll
                    for (int bj = 0; bj < 2; ++bj)
#pragma unroll
                        for (int n = 0; n < 2; ++n) { v[bj][n] = acc[ai][bj][m][n] * r; ss += dot4(v[bj][n]); }
                    ss += __shfl_xor(ss, 16); ss += __shfl_xor(ss, 32);
                    const float rn = rsqrtf(ss * (1.f / 64.f) + EPS) * sc;
#pragma unroll
                    for (int bj = 0; bj < 2; ++bj) *(u32x4*)(base + (size_t)row * D + 32 * bj) = pack8(v[bj][0] * rn * gv[bj][0], v[bj][1] * rn * gv[bj][1]); }
            return;
        }
        int act = 0, ld = ld0; float sc = 1.f; bf16_t* base = o0 + u.pn * 256;
        if (mode == MODE_RET_QKG) { if (u.pn < 4) { ld = 1024; } else if (u.pn < 8) { base = o1 + (u.pn - 4) * 256; ld = 1024; sc = 0.0625f; } else { base = o2 + (u.pn - 8) * 256; ld = 2048; act = 1; } }
        else if (mode == MODE_SQRELU) { act = 2; }
        base += wc * 32 + 8 * fq;
#pragma unroll
        for (int ai = 0; ai < 2; ++ai)
#pragma unroll
            for (int m = 0; m < 4; ++m) { const int row = row0 + ai * 128 + m * 16; const float r = rs[ai][m] * sc;
#pragma unroll
                for (int bj = 0; bj < 2; ++bj) { f32x4 v0 = acc[ai][bj][m][0] * r, v1 = acc[ai][bj][m][1] * r;
                    if (act == 1) { v0.x *= sigmoidf_(v0.x); v0.y *= sigmoidf_(v0.y); v0.z *= sigmoidf_(v0.z); v0.w *= sigmoidf_(v0.w); v1.x *= sigmoidf_(v1.x); v1.y *= sigmoidf_(v1.y); v1.z *= sigmoidf_(v1.z); v1.w *= sigmoidf_(v1.w); }
                    else if (act == 2) { v0.x = fmaxf(v0.x, 0.f); v0.y = fmaxf(v0.y, 0.f); v0.z = fmaxf(v0.z, 0.f); v0.w = fmaxf(v0.w, 0.f); v1.x = fmaxf(v1.x, 0.f); v1.y = fmaxf(v1.y, 0.f); v1.z = fmaxf(v1.z, 0.f); v1.w = fmaxf(v1.w, 0.f); v0 = v0 * v0; v1 = v1 * v1; }
                    *(u32x4*)(base + (size_t)row * ld + bj * 128) = pack8(v0, v1); } }
    }
};

__device__ __forceinline__ int rowmap(int nn, int rmode) {
    if (rmode == 1) return nn < 2048 ? ((nn & ~255) + ((nn >> 5) & 1) * 128 + ((nn >> 6) & 3) * 32 + (nn & 31)) : nn;
    if (rmode == 2) return nn < 2048 ? nn : (nn < 4096 ? nn + 2048 : nn - 2048);
    return nn;
}
__device__ __forceinline__ void xpose_item(const float* W, int N, int K, bf16_t* WT, int item, int rmode, const float* gain, int gmask, float gscale, LAS float* scr, int lane) {
    const int nblk = N / 32, kb = item / nblk, nb = item - kb * nblk, k0 = 64 * kb, n0 = 32 * nb;
#pragma unroll 8
    for (int i = 0; i < 32; ++i) { const int kk = 2 * i + (lane >> 5); float v = W[(size_t)(k0 + kk) * N + n0 + (lane & 31)]; if (gain) v *= gain[(k0 + kk) & gmask] * gscale; scr[kk * 33 + (lane & 31)] = v; }
    asm volatile("s_waitcnt lgkmcnt(0)" ::: "memory");
    const int c = lane & 7;
#pragma unroll
    for (int j = 0; j < 4; ++j) { const int n = (lane >> 3) + 8 * j; const LAS float* s = scr + (8 * c) * 33 + n; const int row = rowmap(n0 + n, rmode);
        u32x4 o; o.x = pk2(s[0 * 33], s[1 * 33]); o.y = pk2(s[2 * 33], s[3 * 33]); o.z = pk2(s[4 * 33], s[5 * 33]); o.w = pk2(s[6 * 33], s[7 * 33]);
        *(u32x4*)(WT + (size_t)row * K + k0 + 8 * c) = o; }
    asm volatile("s_waitcnt lgkmcnt(0)" ::: "memory");
}

__device__ __forceinline__ float lambda_init_of(int i) { asm volatile("" : "+s"(i)); return i == 0 ? 0.2f : 0.47071301834f; }

__device__ __forceinline__ void convert_in(int i, LAS unsigned char* lds, int G) {
    KArgs a = kargs();
    const int tid = opaque_tid(), lane = tid & 63, wave = __builtin_amdgcn_readfirstlane(tid >> 6), gw = opaque_bid() * NWAVES + wave, ngw = G * NWAVES;
    LAS float* scr = (LAS float*)(lds + wave * 16384); const int j = i >> 1;
    bf16_t* WT = (bf16_t*)(a->ws + WS_WIN); const float* gain = a->norm_mix + i * D;
    if ((i & 1) == 0) { const float* W = a->a_w_qkv + (size_t)j * D * 3072; for (int it = gw; it < 16 * 96; it += ngw) xpose_item(W, 3072, D, WT, it, 1, gain, 1023, 1.f, scr, lane); }
    else { const float* W = a->r_w_in + (size_t)j * D * 6144; for (int it = gw; it < 16 * 192; it += ngw) xpose_item(W, 6144, D, WT, it, 2, gain, 1023, 1.f, scr, lane); }
}
__device__ __forceinline__ void convert_rest(int i, LAS unsigned char* lds, int G) {
    KArgs a = kargs();
    const int tid = opaque_tid(), lane = tid & 63, wave = __builtin_amdgcn_readfirstlane(tid >> 6), gw = opaque_bid() * NWAVES + wave, ngw = G * NWAVES;
    LAS float* scr = (LAS float*)(lds + wave * 16384); const int j = i >> 1; const bool attn = (i & 1) == 0;
    const int n_out = attn ? 512 : 1024, n_1 = 2048, n_2 = 2048, n_up = 128, n_g = 512, total = n_out + n_1 + n_2 + n_up + n_g;
    for (int it = gw; it < total; it += ngw) {
        int r = it;
        if (r < n_out) { if (attn) xpose_item(a->a_w_o + (size_t)j * D * D, D, D, (bf16_t*)(a->ws + WS_WOUT), r, 0, a->a_g_sub + j * 128, 127, 1.f - lambda_init_of(i), scr, lane);
                         else xpose_item(a->r_w_out + (size_t)j * 2048 * D, D, 2048, (bf16_t*)(a->ws + WS_WOUT), r, 0, a->r_g_gn + j * 512, 511, 1.f, scr, lane); continue; } r -= n_out;
        if (r < n_1) { xpose_item(a->mlp_w1 + (size_t)i * D * FF, FF, D, (bf16_t*)(a->ws + WS_W1), r, 0, a->norm_mlp + i * D, 1023, 1.f, scr, lane); continue; } r -= n_1;
        if (r < n_2) { xpose_item(a->mlp_w2 + (size_t)i * FF * D, D, FF, (bf16_t*)(a->ws + WS_W2), r, 0, nullptr, 0, 1.f, scr, lane); continue; } r -= n_2;
        if (r < n_up) { xpose_item(a->pe_w_up + (size_t)i * PLE * D, D, PLE, (bf16_t*)(a->ws + WS_WUP), r, 0, nullptr, 0, 1.f, scr, lane); continue; } r -= n_up;
        xpose_item(a->pe_w_gate + (size_t)i * D * D, D, D, (bf16_t*)(a->ws + WS_WGATE), r, 0, a->norm_pe + i * D, 1023, 1.f, scr, lane);
    }
    const f32x4* ps = (const f32x4*)(a->p + (size_t)i * M * PLE); u32x4* pd = (u32x4*)(a->ws + WS_PB);
    const int gt = gw * 64 + lane, ngt = ngw * 64;
    for (int q = gt; q < M * PLE / 8; q += ngt) { const f32x4 v0 = ps[2 * q], v1 = ps[2 * q + 1]; pd[q] = pack8(v0, v1); }
}

__device__ __forceinline__ void prologue_rows(int G) {
    KArgs a = kargs();
    const int tid = opaque_tid(), lane = tid & 63, wave = __builtin_amdgcn_readfirstlane(tid >> 6), gw = opaque_bid() * NWAVES + wave, ngw = G * NWAVES;
    float* ssp = (float*)(a->ws + WS_SSP0); bf16_t* XB = (bf16_t*)(a->ws + WS_XB);
    for (int m = gw; m < M; m += ngw) {
        const f32x4* xr = (const f32x4*)(a->x + (size_t)m * D) + lane; u32x2* xb = (u32x2*)(XB + (size_t)m * D) + lane;
        float s = 0.f;
#pragma unroll
        for (int j = 0; j < 4; ++j) { const f32x4 v = xr[64 * j]; s += dot4(v); u32x2 w; w.x = pk2(v.x, v.y); w.y = pk2(v.z, v.w); xb[64 * j] = w; }
#pragma unroll
        for (int o = 1; o < 64; o <<= 1) s += __shfl_xor(s, o);
        if (lane < 16) ssp[(size_t)m * 16 + lane] = (lane == 0) ? s : 0.f;
    }
    if (gw < NBATCH) { const float* xr = a->x + (size_t)gw * SEQ * D; float* xs0 = (float*)(a->ws + WS_SIDE) + SD_XS + gw * D;
        for (int k = lane; k < D; k += 64) xs0[k] = xr[k]; }
}

__device__ __forceinline__ void attn_phase(LAS unsigned char* lds, const bf16_t* Q, const bf16_t* K, const bf16_t* VT, bf16_t* O, float lam, int G) {
    const int tid = opaque_tid(), lane = tid & 63, w = __builtin_amdgcn_readfirstlane(tid >> 6), r = lane & 31, hh = lane >> 5;
    LAS unsigned char* Ks = lds; LAS unsigned char* Vs = lds + 64 * 272; LAS unsigned char* Qs = lds + 36864 + w * 8704 + r * 272 + 16 * hh;
    for (int v = opaque_bid(); v < 256; v += G) {
        const int xcd = v & 7, slot = v >> 3, bh = xcd * 16 + (slot >> 1), par = slot & 1, b = bh >> 3, h = bh & 7;
        const float slope2 = fexp2(-(float)(h + 1)) * LOG2E;
        const size_t tokb = (size_t)b * SEQ;
        for (int ui = 0; ui < 4; ++ui) {
            const int qb = par ? (ui == 0 ? 1 : ui == 1 ? 2 : ui == 2 ? 5 : 6) : (ui == 0 ? 0 : ui == 1 ? 3 : ui == 2 ? 4 : 7);
            const int q0 = qb * 256, q0w = q0 + 32 * w, nt = (q0 + 256) >> 6;
            { const int t2 = opaque_tid(); const bf16_t* qp = Q + (tokb + q0w + (t2 & 31)) * D + h * 128 + 8 * ((t2 >> 5) & 1);
#pragma unroll
              for (int c = 0; c < 2; ++c)
#pragma unroll
                  for (int ks = 0; ks < 4; ++ks) *(LAS bf16x8*)(Qs + (c * 64 + 16 * ks) * 2) = *(const bf16x8*)(qp + c * 64 + 16 * ks); }
            f32x16 o[2][4];
#pragma unroll
            for (int c = 0; c < 2; ++c)
#pragma unroll
                for (int et = 0; et < 4; ++et)
#pragma unroll
                    for (int g = 0; g < 16; ++g) o[c][et][g] = 0.f;
            float mrun[2] = {-1e30f, -1e30f}, lrun[2] = {0.f, 0.f};
            const int kl0 = (tid >> 4) * 272 + (tid & 15) * 16, vl0 = (tid >> 3) * 144 + (tid & 7) * 16;
            const bf16_t* kgb = K + tokb * D + h * 128; const unsigned kof = (unsigned)((tid >> 4) * D + (tid & 15) * 8);
            const bf16_t* vgb = VT + (size_t)(h * 128) * M + tokb; const unsigned vof = (unsigned)((tid >> 3) * M + (tid & 7) * 8);
            for (int t = 0; t < nt; ++t) {
                u32x4 kreg[2], vreg[2];
#pragma unroll
                for (int i = 0; i < 2; ++i) { kreg[i] = *(const u32x4*)(kgb + ((size_t)32 * i * D + (size_t)t * 64 * D) + kof); vreg[i] = *(const u32x4*)(vgb + ((size_t)64 * i * M + t * 64) + vof); }
                __syncthreads();
#pragma unroll
                for (int i = 0; i < 2; ++i) { *(LAS u32x4*)(Ks + kl0 + 32 * i * 272) = kreg[i]; *(LAS u32x4*)(Vs + vl0 + 64 * i * 144) = vreg[i]; }
                __syncthreads();
#pragma unroll
                for (int half = 0; half < 2; ++half) {
                    const int kb = 64 * t + 32 * half;
                    if (kb <= q0w) {
                        const bool diag = (kb == q0w);
                        const float base = slope2 * (float)(kb + 4 * hh);
#pragma unroll
                        for (int c = 0; c < 2; ++c) {
                            f32x16 s;
#pragma unroll
                            for (int g = 0; g < 16; ++g) s[g] = fmaf(slope2, (float)((g & 3) + 8 * (g >> 2)), base);
#pragma unroll
                            for (int ks = 0; ks < 4; ++ks) { const bf16x8 af = *(const LAS bf16x8*)(Ks + (32 * half + r) * 272 + (c * 64 + 16 * ks + 8 * hh) * 2);
                                const bf16x8 bq = *(const LAS bf16x8*)(Qs + (c * 64 + 16 * ks) * 2);
                                s = __builtin_amdgcn_mfma_f32_32x32x16_bf16(af, bq, s, 0, 0, 0); }
                            if (diag) { int rr = r - 4 * hh; asm volatile("" : "+v"(rr));
#pragma unroll
                                for (int g = 0; g < 16; ++g) if ((g & 3) + 8 * (g >> 2) > rr) s[g] = -1e30f; }
                            float mx = s[0];
#pragma unroll
                            for (int g = 1; g < 16; ++g) mx = fmaxf(mx, s[g]);
                            mx = fmaxf(mx, __shfl_xor(mx, 32));
                            const float mnew = fmaxf(mrun[c], mx), alpha = fexp2(mrun[c] - mnew); mrun[c] = mnew;
                            float rsum = 0.f;
#pragma unroll
                            for (int g = 0; g < 16; ++g) { s[g] = fexp2(s[g] - mnew); rsum += s[g]; }
                            lrun[c] = lrun[c] * alpha + rsum;
                            if (__any(alpha != 1.f)) {
#pragma unroll
                                for (int et = 0; et < 4; ++et)
#pragma unroll
                                    for (int g = 0; g < 16; ++g) o[c][et][g] *= alpha; }
                            u32x4 pw0, pw1;
                            pw0.x = pk2(s[0], s[1]); pw0.y = pk2(s[2], s[3]); pw0.z = pk2(s[4], s[5]); pw0.w = pk2(s[6], s[7]);
                            pw1.x = pk2(s[8], s[9]); pw1.y = pk2(s[10], s[11]); pw1.z = pk2(s[12], s[13]); pw1.w = pk2(s[14], s[15]);
                            const bf16x8 pb0 = __builtin_bit_cast(bf16x8, pw0), pb1 = __builtin_bit_cast(bf16x8, pw1);
#pragma unroll
                            for (int et = 0; et < 4; ++et) { const LAS unsigned char* vp = Vs + (32 * et + r) * 144 + (32 * half + 4 * hh) * 2;
                                const s16x4 a0 = *(const LAS s16x4*)(vp), a1 = *(const LAS s16x4*)(vp + 16), a2 = *(const LAS s16x4*)(vp + 32), a3 = *(const LAS s16x4*)(vp + 48);
                                o[c][et] = __builtin_amdgcn_mfma_f32_32x32x16_bf16(__builtin_shufflevector(a0, a1, 0, 1, 2, 3, 4, 5, 6, 7), pb0, o[c][et], 0, 0, 0);
                                o[c][et] = __builtin_amdgcn_mfma_f32_32x32x16_bf16(__builtin_shufflevector(a2, a3, 0, 1, 2, 3, 4, 5, 6, 7), pb1, o[c][et], 0, 0, 0); }
                        }
                    }
                }
            }
            const float l0 = lrun[0] + __shfl_xor(lrun[0], 32), l1 = lrun[1] + __shfl_xor(lrun[1], 32);
            const float i0 = 1.f / l0, i1 = lam / l1; float ss = 0.f;
#pragma unroll
            for (int et = 0; et < 4; ++et)
#pragma unroll
                for (int g = 0; g < 16; ++g) { const float vv = o[0][et][g] * i0 - o[1][et][g] * i1; o[0][et][g] = vv; ss += vv * vv; }
            ss += __shfl_xor(ss, 32);
            const float rn = rsqrtf(ss * (1.f / 128.f) + EPS);
            const int t2 = opaque_tid();
            bf16_t* op = O + (tokb + q0w + (t2 & 31)) * D + h * 128 + 4 * ((t2 >> 5) & 1);
#pragma unroll
            for (int et = 0; et < 4; ++et)
#pragma unroll
                for (int g = 0; g < 4; ++g) { u32x2 wv; wv.x = pk2(o[0][et][4 * g] * rn, o[0][et][4 * g + 1] * rn); wv.y = pk2(o[0][et][4 * g + 2] * rn, o[0][et][4 * g + 3] * rn);
                    *(u32x2*)(op + 32 * et + 8 * g) = wv; }
        }
    }
}


__device__ __forceinline__ void attn_phase2(LAS unsigned char* lds, const bf16_t* Q, const bf16_t* K, const bf16_t* VT, bf16_t* O, float lam, int G) {
    const int tid = opaque_tid(), lane = tid & 63, w = __builtin_amdgcn_readfirstlane(tid >> 6), r = lane & 31, hh = lane >> 5;
    const int qsub = w & 3, c = w >> 2;
    LAS float* EX = (LAS float*)(lds + 71680);
    const int kl0 = (tid >> 4) * 272 + (tid & 15) * 16, vl0 = 17408 + (tid >> 3) * 136 + (tid & 7) * 16;
    for (int v = opaque_bid(); v < 256; v += G) {
      const int xcd = v & 7, slot = v >> 3, grp = slot >> 4, member = slot & 15;
      for (int rd = 0; rd < 8; ++rd) {
        const int bh = xcd * 16 + rd * 2 + grp, b = bh >> 3, h = bh & 7;
        const float slope2 = fexp2(-(float)(h + 1)) * LOG2E;
        const size_t tokb = (size_t)b * SEQ;
        const bf16_t* kg0 = K + (tokb + (tid >> 4)) * D + h * 128 + (tid & 15) * 8;
        const bf16_t* vg0 = VT + (size_t)(h * 128 + (tid >> 3)) * M + tokb + (tid & 7) * 8;
        for (int ui = 0; ui < 1; ++ui) {
            const int qa = (member + (rd >> 1)) & 15, qb = (rd & 1) ? 15 - qa : qa;
            const int q0 = qb * 128, q0w = q0 + 32 * qsub, nt = (q0 + 128) >> 6;
            u32x4 kreg[2], vreg[2];
#pragma unroll
            for (int i = 0; i < 2; ++i) { kreg[i] = *(const u32x4*)(kg0 + (size_t)32 * i * D); vreg[i] = *(const u32x4*)(vg0 + (size_t)64 * i * M); }
            bf16x8 qf[4];
            { const bf16_t* qp = Q + (tokb + q0w + r) * D + h * 128 + c * 64 + 8 * hh;
#pragma unroll
              for (int ks = 0; ks < 4; ++ks) qf[ks] = *(const bf16x8*)(qp + 16 * ks); }
            f32x16 o[4];
#pragma unroll
            for (int et = 0; et < 4; ++et)
#pragma unroll
                for (int g = 0; g < 16; ++g) o[et][g] = 0.f;
            float mrun = -1e30f, lrun = 0.f;
#pragma unroll
            for (int i = 0; i < 2; ++i) { *(LAS u32x4*)(lds + kl0 + 32 * i * 272) = kreg[i]; *(LAS u32x2*)(lds + vl0 + 64 * i * 136) = (u32x2){vreg[i].x, vreg[i].y}; *(LAS u32x2*)(lds + vl0 + 64 * i * 136 + 8) = (u32x2){vreg[i].z, vreg[i].w}; }
            for (int t = 0; t < nt; ++t) {
                __syncthreads();
                if (t + 1 < nt) {
#pragma unroll
                    for (int i = 0; i < 2; ++i) { kreg[i] = *(const u32x4*)(kg0 + (size_t)32 * i * D + (size_t)(t + 1) * 64 * D); vreg[i] = *(const u32x4*)(vg0 + (size_t)64 * i * M + (t + 1) * 64); } }
                const LAS unsigned char* Kt = lds + (t & 1) * 35840; const LAS unsigned char* Vt = Kt + 17408;
                const int kb0 = 64 * t;
                if (kb0 <= q0w) {
                    const bool act1 = (kb0 + 32 <= q0w);
                    const float base0 = slope2 * (float)(kb0 + 4 * hh);
                    f32x16 s0, s1;
#pragma unroll
                    for (int g = 0; g < 16; ++g) { s0[g] = fmaf(slope2, (float)((g & 3) + 8 * (g >> 2)), base0); s1[g] = s0[g] + slope2 * 32.f; }
                    bf16x8 ka[4], kc[4];
#pragma unroll
                    for (int ks = 0; ks < 4; ++ks) ka[ks] = *(const LAS bf16x8*)(Kt + r * 272 + (c * 64 + 16 * ks + 8 * hh) * 2);
                    if (act1) {
#pragma unroll
                        for (int ks = 0; ks < 4; ++ks) kc[ks] = *(const LAS bf16x8*)(Kt + (32 + r) * 272 + (c * 64 + 16 * ks + 8 * hh) * 2); }
                    else {
#pragma unroll
                        for (int ks = 0; ks < 4; ++ks) kc[ks] = ka[ks]; }
                    __builtin_amdgcn_sched_barrier(0);
#pragma unroll
                    for (int ks = 0; ks < 4; ++ks) s0 = __builtin_amdgcn_mfma_f32_32x32x16_bf16(ka[ks], qf[ks], s0, 0, 0, 0);
                    if (act1) {
#pragma unroll
                        for (int ks = 0; ks < 4; ++ks) s1 = __builtin_amdgcn_mfma_f32_32x32x16_bf16(kc[ks], qf[ks], s1, 0, 0, 0); }
                    s16x4 va[4][4];
#pragma unroll
                    for (int et = 0; et < 4; ++et) { const LAS unsigned char* vp = Vt + (32 * et + r) * 136 + (4 * hh) * 2;
                        va[et][0] = *(const LAS s16x4*)(vp); va[et][1] = *(const LAS s16x4*)(vp + 16); va[et][2] = *(const LAS s16x4*)(vp + 32); va[et][3] = *(const LAS s16x4*)(vp + 48); }
                    __builtin_amdgcn_sched_barrier(0);
                    { int rr = r - 4 * hh; asm volatile("" : "+v"(rr));
                      if (kb0 == q0w) {
#pragma unroll
                          for (int g = 0; g < 16; ++g) if ((g & 3) + 8 * (g >> 2) > rr) s0[g] = -1e30f; }
                      if (kb0 + 32 == q0w) {
#pragma unroll
                          for (int g = 0; g < 16; ++g) if ((g & 3) + 8 * (g >> 2) > rr) s1[g] = -1e30f; } }
                    float mx = s0[0];
#pragma unroll
                    for (int g = 1; g < 16; ++g) mx = fmaxf(mx, s0[g]);
                    if (act1) {
#pragma unroll
                        for (int g = 0; g < 16; ++g) mx = fmaxf(mx, s1[g]); }
                    mx = fmaxf(mx, __shfl_xor(mx, 32));
                    if (__any(mx > mrun + 12.f)) { const float mnew = fmaxf(mrun, mx), alpha = fexp2(mrun - mnew); mrun = mnew; lrun *= alpha;
#pragma unroll
                        for (int et = 0; et < 4; ++et)
#pragma unroll
                            for (int g = 0; g < 16; ++g) o[et][g] *= alpha; }
                    float rsum = 0.f;
#pragma unroll
                    for (int g = 0; g < 16; ++g) { s0[g] = fexp2(s0[g] - mrun); rsum += s0[g]; }
                    { u32x4 pw0, pw1;
                      pw0.x = pk2(s0[0], s0[1]); pw0.y = pk2(s0[2], s0[3]); pw0.z = pk2(s0[4], s0[5]); pw0.w = pk2(s0[6], s0[7]);
                      pw1.x = pk2(s0[8], s0[9]); pw1.y = pk2(s0[10], s0[11]); pw1.z = pk2(s0[12], s0[13]); pw1.w = pk2(s0[14], s0[15]);
                      const bf16x8 pb0 = __builtin_bit_cast(bf16x8, pw0), pb1 = __builtin_bit_cast(bf16x8, pw1);
                      __builtin_amdgcn_sched_barrier(0);
#pragma unroll
                      for (int et = 0; et < 4; ++et) {
                          o[et] = __builtin_amdgcn_mfma_f32_32x32x16_bf16(__builtin_shufflevector(va[et][0], va[et][1], 0, 1, 2, 3, 4, 5, 6, 7), pb0, o[et], 0, 0, 0);
                          o[et] = __builtin_amdgcn_mfma_f32_32x32x16_bf16(__builtin_shufflevector(va[et][2], va[et][3], 0, 1, 2, 3, 4, 5, 6, 7), pb1, o[et], 0, 0, 0); } }
                    if (act1) {
#pragma unroll
                        for (int et = 0; et < 4; ++et) { const LAS unsigned char* vp = Vt + (32 * et + r) * 136 + (32 + 4 * hh) * 2;
                            va[et][0] = *(const LAS s16x4*)(vp); va[et][1] = *(const LAS s16x4*)(vp + 16); va[et][2] = *(const LAS s16x4*)(vp + 32); va[et][3] = *(const LAS s16x4*)(vp + 48); }
                        __builtin_amdgcn_sched_barrier(0);
#pragma unroll
                        for (int g = 0; g < 16; ++g) { s1[g] = fexp2(s1[g] - mrun); rsum += s1[g]; }
                        u32x4 pw0, pw1;
                        pw0.x = pk2(s1[0], s1[1]); pw0.y = pk2(s1[2], s1[3]); pw0.z = pk2(s1[4], s1[5]); pw0.w = pk2(s1[6], s1[7]);
                        pw1.x = pk2(s1[8], s1[9]); pw1.y = pk2(s1[10], s1[11]); pw1.z = pk2(s1[12], s1[13]); pw1.w = pk2(s1[14], s1[15]);
                        const bf16x8 pb0 = __builtin_bit_cast(bf16x8, pw0), pb1 = __builtin_bit_cast(bf16x8, pw1);
                        __builtin_amdgcn_sched_barrier(0);
#pragma unroll
                        for (int et = 0; et < 4; ++et) {
                            o[et] = __builtin_amdgcn_mfma_f32_32x32x16_bf16(__builtin_shufflevector(va[et][0], va[et][1], 0, 1, 2, 3, 4, 5, 6, 7), pb0, o[et], 0, 0, 0);
                            o[et] = __builtin_amdgcn_mfma_f32_32x32x16_bf16(__builtin_shufflevector(va[et][2], va[et][3], 0, 1, 2, 3, 4, 5, 6, 7), pb1, o[et], 0, 0, 0); } }
                    lrun += rsum;
                }
                if (t + 1 < nt) { LAS unsigned char* nb = lds + ((t + 1) & 1) * 35840;
#pragma unroll
                    for (int i = 0; i < 2; ++i) { *(LAS u32x4*)(nb + kl0 + 32 * i * 272) = kreg[i]; *(LAS u32x2*)(nb + vl0 + 64 * i * 136) = (u32x2){vreg[i].x, vreg[i].y}; *(LAS u32x2*)(nb + vl0 + 64 * i * 136 + 8) = (u32x2){vreg[i].z, vreg[i].w}; } }
            }
            const float l = lrun + __shfl_xor(lrun, 32);
            if (c == 1) { const float sc = lam / l;
#pragma unroll
                for (int et = 0; et < 4; ++et)
#pragma unroll
                    for (int g = 0; g < 16; ++g) EX[(qsub * 64 + et * 16 + g) * 64 + lane] = o[et][g] * sc; }
            __syncthreads();
            if (c == 0) { const float inv = 1.f / l; float ss = 0.f;
#pragma unroll
                for (int et = 0; et < 4; ++et)
#pragma unroll
                    for (int g = 0; g < 16; ++g) { const float vv = o[et][g] * inv - EX[(qsub * 64 + et * 16 + g) * 64 + lane]; o[et][g] = vv; ss += vv * vv; }
                ss += __shfl_xor(ss, 32);
                const float rn = rsqrtf(ss * (1.f / 128.f) + EPS);
                bf16_t* op = O + (tokb + q0w + r) * D + h * 128 + 4 * hh;
#pragma unroll
                for (int et = 0; et < 4; ++et)
#pragma unroll
                    for (int g = 0; g < 4; ++g) { u32x2 wv; wv.x = pk2(o[et][4 * g] * rn, o[et][4 * g + 1] * rn); wv.y = pk2(o[et][4 * g + 2] * rn, o[et][4 * g + 3] * rn);
                        *(u32x2*)(op + 32 * et + 8 * g) = wv; } }
        }
      }
    }
}

__device__ __forceinline__ void ret_phase(LAS unsigned char* lds, const bf16_t* Q, const bf16_t* K, const bf16_t* VT, bf16_t* TG, float* SSO, int G) {
    const int tid = opaque_tid(), lane = tid & 63, w = __builtin_amdgcn_readfirstlane(tid >> 6), r = lane & 31, hh = lane >> 5;
    const int ib = w & 3, eb = w >> 2, db = w;
    LAS unsigned char* Kn = lds; LAS unsigned char* Vn = lds + 128 * 528; LAS unsigned char* RT = lds + 128 * 528 + 64 * 272;
    for (int v = opaque_bid(); v < 256; v += G) {
        const int xcd = v & 7, slot = v >> 3;
        for (int k2 = 0; k2 < 2; ++k2) {
            const int jj = slot + 32 * k2, bh = xcd * 8 + (jj >> 3), vs = jj & 7, b = bh >> 2, h = bh & 3;
            const float l2g = log2f(1.f - fexp2(-5.f - (float)h)), cdec = fexp2(128.f * l2g);
            const size_t tokb = (size_t)b * SEQ;
            f32x16 racc[2];
#pragma unroll
            for (int e2 = 0; e2 < 2; ++e2)
#pragma unroll
                for (int g = 0; g < 16; ++g) racc[e2][g] = 0.f;
            __syncthreads();
            const int kl0 = (tid >> 5) * 528 + (tid & 31) * 16, vl0 = (tid >> 4) * 272 + (tid & 15) * 16;
            const bf16_t* kg0 = K + (tokb + (tid >> 5)) * D + h * 256 + (tid & 31) * 8;
            const bf16_t* vg0 = VT + (size_t)(h * 512 + vs * 64 + (tid >> 4)) * M + tokb + (tid & 15) * 8;
            u32x4 kreg[8], vreg[2];
#pragma unroll
            for (int i = 0; i < 8; ++i) kreg[i] = *(const u32x4*)(kg0 + (size_t)16 * i * D);
#pragma unroll
            for (int i = 0; i < 2; ++i) vreg[i] = *(const u32x4*)(vg0 + (size_t)32 * i * M);
            for (int n = 0; n < 16; ++n) {
                const size_t tok0 = tokb + 128 * n;
#pragma unroll
                for (int i = 0; i < 8; ++i) *(LAS u32x4*)(Kn + kl0 + 16 * i * 528) = kreg[i];
#pragma unroll
                for (int i = 0; i < 2; ++i) *(LAS u32x4*)(Vn + vl0 + 32 * i * 272) = vreg[i];
                __syncthreads();
                if (n + 1 < 16) {
#pragma unroll
                    for (int i = 0; i < 8; ++i) kreg[i] = *(const u32x4*)(kg0 + (size_t)16 * i * D + (size_t)(n + 1) * 128 * D);
#pragma unroll
                    for (int i = 0; i < 2; ++i) vreg[i] = *(const u32x4*)(vg0 + (size_t)32 * i * M + (n + 1) * 128); }
                bf16x8 qf[16];
                { const bf16_t* qp = Q + (tok0 + 32 * ib + r) * D + h * 256 + 8 * hh;
#pragma unroll
                  for (int s = 0; s < 16; ++s) qf[s] = *(const bf16x8*)(qp + 16 * s); }
                f32x16 acc;
#pragma unroll
                for (int g = 0; g < 16; ++g) acc[g] = 0.f;
                if (n > 0) {
#pragma unroll
                    for (int s = 0; s < 16; ++s) { const bf16x8 af = *(const LAS bf16x8*)(RT + (32 * eb + r) * 528 + (16 * s + 8 * hh) * 2); acc = __builtin_amdgcn_mfma_f32_32x32x16_bf16(af, qf[s], acc, 0, 0, 0); }
#pragma unroll
                    for (int g = 0; g < 16; ++g) acc[g] *= cdec; }
                for (int jb = 0; jb <= ib; ++jb) {
                    f32x16 st;
#pragma unroll
                    for (int g = 0; g < 16; ++g) st[g] = 0.f;
#pragma unroll
                    for (int s = 0; s < 16; ++s) { const bf16x8 af = *(const LAS bf16x8*)(Kn + (32 * jb + r) * 528 + (16 * s + 8 * hh) * 2); st = __builtin_amdgcn_mfma_f32_32x32x16_bf16(af, qf[s], st, 0, 0, 0); }
                    if (jb == ib) { int rr = r - 4 * hh; asm volatile("" : "+v"(rr));
#pragma unroll
                        for (int g = 0; g < 16; ++g) if ((g & 3) + 8 * (g >> 2) > rr) st[g] = 0.f; }
                    u32x4 pw0, pw1;
                    pw0.x = pk2(st[0], st[1]); pw0.y = pk2(st[2], st[3]); pw0.z = pk2(st[4], st[5]); pw0.w = pk2(st[6], st[7]);
                    pw1.x = pk2(st[8], st[9]); pw1.y = pk2(st[10], st[11]); pw1.z = pk2(st[12], st[13]); pw1.w = pk2(st[14], st[15]);
                    const LAS unsigned char* vp = Vn + (32 * eb + r) * 272 + (32 * jb + 4 * hh) * 2;
                    const s16x4 a0 = *(const LAS s16x4*)(vp), a1 = *(const LAS s16x4*)(vp + 16), a2 = *(const LAS s16x4*)(vp + 32), a3 = *(const LAS s16x4*)(vp + 48);
                    acc = __builtin_amdgcn_mfma_f32_32x32x16_bf16(__builtin_shufflevector(a0, a1, 0, 1, 2, 3, 4, 5, 6, 7), __builtin_bit_cast(bf16x8, pw0), acc, 0, 0, 0);
                    acc = __builtin_amdgcn_mfma_f32_32x32x16_bf16(__builtin_shufflevector(a2, a3, 0, 1, 2, 3, 4, 5, 6, 7), __builtin_bit_cast(bf16x8, pw1), acc, 0, 0, 0);
                }
                { const int i = 32 * ib + r; const float fac = fexp2(l2g * (float)(i - 127)); float ss = 0.f;
#pragma unroll
                  for (int g = 0; g < 16; ++g) { acc[g] *= fac; ss += acc[g] * acc[g]; }
                  ss += __shfl_xor(ss, 32);
                  const size_t tok = tok0 + i;
                  if (hh == 0) SSO[tok * 64 + h * 16 + vs * 2 + eb] = ss;
                  bf16_t* gp = TG + tok * 2048 + h * 512 + vs * 64 + 32 * eb + 4 * hh;
#pragma unroll
                  for (int g = 0; g < 4; ++g) { const u32x2 gw = *(const u32x2*)(gp + 8 * g); u32x2 ov;
                      ov.x = pk2(acc[4 * g] * bf_lo(gw.x), acc[4 * g + 1] * bf_hi(gw.x)); ov.y = pk2(acc[4 * g + 2] * bf_lo(gw.y), acc[4 * g + 3] * bf_hi(gw.y)); *(u32x2*)(gp + 8 * g) = ov; } }
#pragma unroll
                for (int e2 = 0; e2 < 2; ++e2)
#pragma unroll
                    for (int g = 0; g < 16; ++g) racc[e2][g] *= cdec;
#pragma unroll
                for (int s = 0; s < 8; ++s) { const LAS unsigned short* kp = (const LAS unsigned short*)Kn + (16 * s + 8 * hh) * 264 + 32 * db + r;
                    u32x4 aw;
                    aw.x = (unsigned)kp[0] | ((unsigned)kp[264] << 16); aw.y = (unsigned)kp[2 * 264] | ((unsigned)kp[3 * 264] << 16);
                    aw.z = (unsigned)kp[4 * 264] | ((unsigned)kp[5 * 264] << 16); aw.w = (unsigned)kp[6 * 264] | ((unsigned)kp[7 * 264] << 16);
                    const bf16x8 af = __builtin_bit_cast(bf16x8, aw);
#pragma unroll
                    for (int e2 = 0; e2 < 2; ++e2) { const bf16x8 bb = *(const LAS bf16x8*)(Vn + (32 * e2 + r) * 272 + (16 * s + 8 * hh) * 2); racc[e2] = __builtin_amdgcn_mfma_f32_32x32x16_bf16(af, bb, racc[e2], 0, 0, 0); } }
                __syncthreads();
#pragma unroll
                for (int e2 = 0; e2 < 2; ++e2)
#pragma unroll
                    for (int g = 0; g < 4; ++g) { u32x2 wv; wv.x = pk2(racc[e2][4 * g], racc[e2][4 * g + 1]); wv.y = pk2(racc[e2][4 * g + 2], racc[e2][4 * g + 3]);
                        *(LAS u32x2*)(RT + (32 * e2 + r) * 528 + (32 * db + 8 * g + 4 * hh) * 2) = wv; }
            }
        }
    }
}


__device__ __forceinline__ float bf2f(bf16_t v) { return __uint_as_float((unsigned)v << 16); }
__device__ __forceinline__ void attn_naive(const bf16_t* Q, const bf16_t* K, const bf16_t* VT, bf16_t* O, float lam, int G) {
    const int tid = opaque_tid(), lane = tid & 63, wave = __builtin_amdgcn_readfirstlane(tid >> 6), gw = opaque_bid() * NWAVES + wave, ngw = G * NWAVES;
    for (int row = gw; row < NBATCH * 8 * SEQ; row += ngw) {
        const int q = row % SEQ, bh = row / SEQ, h = bh & 7, b = bh >> 3; const size_t tokb = (size_t)b * SEQ;
        const float slope2 = fexp2(-(float)(h + 1)) * LOG2E;
        float oc[2][2]; float res0 = 0.f, res1 = 0.f;
        for (int c = 0; c < 2; ++c) {
            const bf16_t* qp = Q + (tokb + q) * D + h * 128 + c * 64;
            float m = -1e30f, l = 0.f;
            for (int k0 = 0; k0 <= q; k0 += 64) { const int k = k0 + lane; float sc = -1e30f;
                if (k <= q) { const bf16_t* kp = K + (tokb + k) * D + h * 128 + c * 64; float d = 0.f; for (int t = 0; t < 64; ++t) d = fmaf(bf2f(qp[t]), bf2f(kp[t]), d); sc = d + slope2 * (float)k; }
                const float mn = fmaxf(m, sc); l = l * fexp2(m - mn) + ((k <= q) ? fexp2(sc - mn) : 0.f); m = mn; }
            float mg = m;
#pragma unroll
            for (int o = 1; o < 64; o <<= 1) mg = fmaxf(mg, __shfl_xor(mg, o));
            l = l * fexp2(m - mg);
#pragma unroll
            for (int o = 1; o < 64; o <<= 1) l += __shfl_xor(l, o);
            float o0 = 0.f, o1 = 0.f;
            for (int k0 = 0; k0 <= q; k0 += 64) { const int k = k0 + lane; float pv = 0.f;
                if (k <= q) { const bf16_t* kp = K + (tokb + k) * D + h * 128 + c * 64; float d = 0.f; for (int t = 0; t < 64; ++t) d = fmaf(bf2f(qp[t]), bf2f(kp[t]), d); pv = fexp2(d + slope2 * (float)k - mg); }
                const int nk = (q - k0 + 1) < 64 ? (q - k0 + 1) : 64;
                for (int jj = 0; jj < nk; ++jj) { const float pj = __shfl(pv, jj); const size_t tk = tokb + k0 + jj;
                    o0 = fmaf(pj, bf2f(VT[(size_t)(h * 128 + lane) * M + tk]), o0); o1 = fmaf(pj, bf2f(VT[(size_t)(h * 128 + 64 + lane) * M + tk]), o1); } }
            oc[c][0] = o0 / l; oc[c][1] = o1 / l;
        }
        res0 = oc[0][0] - lam * oc[1][0]; res1 = oc[0][1] - lam * oc[1][1];
        float ss = res0 * res0 + res1 * res1;
#pragma unroll
        for (int o = 1; o < 64; o <<= 1) ss += __shfl_xor(ss, o);
        const float rn = rsqrtf(ss * (1.f / 128.f) + EPS);
        bf16_t* op = O + (tokb + q) * D + h * 128;
        op[lane] = (bf16_t)(pk2(res0 * rn, 0.f) & 0xffffu); op[64 + lane] = (bf16_t)(pk2(res1 * rn, 0.f) & 0xffffu);
    }
}
__device__ __forceinline__ void ret_naive(const bf16_t* Q, const bf16_t* K, const bf16_t* VT, bf16_t* TG, float* SSO, int G) {
    const int tid = opaque_tid(), lane = tid & 63, wave = __builtin_amdgcn_readfirstlane(tid >> 6), gw = opaque_bid() * NWAVES + wave, ngw = G * NWAVES;
    for (int row = gw; row < NBATCH * 4 * SEQ; row += ngw) {
        const int i = row % SEQ, bh = row / SEQ, h = bh & 3, b = bh >> 2; const size_t tokb = (size_t)b * SEQ;
        const float l2g = log2f(1.f - fexp2(-5.f - (float)h));
        const bf16_t* qp = Q + (tokb + i) * D + h * 256;
        float o[8];
#pragma unroll
        for (int t = 0; t < 8; ++t) o[t] = 0.f;
        for (int j0 = 0; j0 <= i; j0 += 64) { const int j = j0 + lane; float wv = 0.f;
            if (j <= i) { const bf16_t* kp = K + (tokb + j) * D + h * 256; float d = 0.f; for (int t = 0; t < 256; ++t) d = fmaf(bf2f(qp[t]), bf2f(kp[t]), d);
                wv = d * fexp2(l2g * (float)((i - j) - (127 - (j & 127)))); }
            const int nj = (i - j0 + 1) < 64 ? (i - j0 + 1) : 64;
            for (int jj = 0; jj < nj; ++jj) { const float wj = __shfl(wv, jj); const size_t tk = tokb + j0 + jj;
#pragma unroll
                for (int t = 0; t < 8; ++t) o[t] = fmaf(wj, bf2f(VT[(size_t)(h * 512 + 64 * t + lane) * M + tk]), o[t]); } }
        float ss = 0.f;
#pragma unroll
        for (int t = 0; t < 8; ++t) ss += o[t] * o[t];
#pragma unroll
        for (int of = 1; of < 64; of <<= 1) ss += __shfl_xor(ss, of);
        const size_t tok = tokb + i;
        if (lane < 16) SSO[tok * 64 + h * 16 + lane] = (lane == 0) ? ss : 0.f;
        bf16_t* gp = TG + tok * 2048 + h * 512;
#pragma unroll
        for (int t = 0; t < 8; ++t) gp[64 * t + lane] = (bf16_t)(pk2(o[t] * bf2f(gp[64 * t + lane]), 0.f) & 0xffffu);
    }
}

__device__ __forceinline__ void ret_norm_phase(bf16_t* TG, const float* SSO, int G) {
    const int tid = opaque_tid(), lane = tid & 63, wave = __builtin_amdgcn_readfirstlane(tid >> 6), gw = opaque_bid() * NWAVES + wave, ngw = G * NWAVES;
    for (int idx0 = gw * 4; idx0 < M * 4; idx0 += ngw * 4) {
        float sp[4]; u32x4 v[4];
#pragma unroll
        for (int u = 0; u < 4; ++u) { sp[u] = (lane < 16) ? SSO[(size_t)(idx0 + u) * 16 + lane] : 0.f; v[u] = *((const u32x4*)(TG + (size_t)(idx0 + u) * 512) + lane); }
#pragma unroll
        for (int u = 0; u < 4; ++u) { float s = sp[u];
#pragma unroll
            for (int o = 1; o < 16; o <<= 1) s += __shfl_xor(s, o);
            s = __shfl(s, 0);
            const float rn = rsqrtf(s * (1.f / 512.f) + EPS); u32x4 o;
            o.x = pk2(bf_lo(v[u].x) * rn, bf_hi(v[u].x) * rn); o.y = pk2(bf_lo(v[u].y) * rn, bf_hi(v[u].y) * rn); o.z = pk2(bf_lo(v[u].z) * rn, bf_hi(v[u].z) * rn); o.w = pk2(bf_lo(v[u].w) * rn, bf_hi(v[u].w) * rn);
            *((u32x4*)(TG + (size_t)(idx0 + u) * 512) + lane) = o; }
    }
}

enum { SK_PROJ = 0, SK_OUT = 1, SK_W1 = 2, SK_UP = 3, SK_W2 = 4, SK_GATE = 5 };
__device__ __forceinline__ void side_step(int kind, int i, int sv, LAS unsigned char* lds, int G, int boff = 0) {
    KArgs a = kargs(); const int tid = opaque_tid(), lane = tid & 63, wave = __builtin_amdgcn_readfirstlane(tid >> 6), bid = opaque_bid();
    float* SD = (float*)(a->ws + WS_SIDE);
    float* XSA = SD + SD_XS; float* XSB = SD + SD_XS + 16384; float* PQ = SD + SD_PRJ;
    const bool attn = (i & 1) == 0; const int j = i >> 1;
    const float* xin = XSA; int xs = 1024, K = 1024, ldw = 1024, nitems = 16; const float* gain = nullptr; const float* W = nullptr;
    if (kind == SK_PROJ) { gain = a->norm_mix + i * D; if (attn) { W = a->a_w_qkv + (size_t)j * D * 3072 + 2048; ldw = 3072; } else { W = a->r_w_in + (size_t)j * D * 6144; ldw = 6144; nitems = 96; } }
    else if (kind == SK_OUT) { xin = SD + SD_AV; xs = 2048; if (attn) { W = a->a_w_o + (size_t)j * D * D; } else { K = 2048; W = a->r_w_out + (size_t)j * 2048 * D; } }
    else if (kind == SK_W1) { xin = XSB; gain = a->norm_mlp + i * D; W = a->mlp_w1 + (size_t)i * D * FF; ldw = FF; nitems = 64; }
    else if (kind == SK_UP) { xin = a->p + (size_t)i * M * PLE; xs = SEQ * PLE; K = PLE; W = a->pe_w_up + (size_t)i * PLE * D; }
    else if (kind == SK_W2) { xin = SD + SD_HS; xs = FF; W = a->mlp_w2 + (size_t)i * FF * D; nitems = 64; }
    else { xin = XSB; gain = a->norm_pe + i * D; W = a->pe_w_gate + (size_t)i * D * D; }
    LAS float* part = (LAS float*)lds;
    LAS float* ssqp = (LAS float*)(lds + 32768);
    LAS float* xst = (LAS float*)(lds + 36864 + wave * 8192);
    for (int it = bid - boff; it < nitems; it += G) {
        if (it < 0) continue;
        const int cg_ = (kind == SK_W2) ? (it & 15) : it, kq = (kind == SK_W2) ? (it >> 4) : 0;
        const int n0 = cg_ * 64, kper = K >> 3, kb0 = kq * 1024 + wave * kper;
        float acc[16];
#pragma unroll
        for (int b = 0; b < 16; ++b) acc[b] = 0.f;
        for (int ks0 = 0; ks0 < kper; ks0 += 128) {
            const int ksn = (kper - ks0) < 128 ? (kper - ks0) : 128, kbase = kb0 + ks0;
            const int nq = ksn >> 2;
            float w[32];
#pragma unroll
            for (int t = 0; t < 32; ++t) w[t] = W[(size_t)(kbase + t) * ldw + n0 + lane];
            for (int q = lane; q < 16 * nq; q += 64) { const int b = q / nq, c4 = (q - b * nq) * 4, k = kbase + c4;
                f32x4 xv = *(const f32x4*)(xin + (size_t)b * xs + k);
                if (kind == SK_GATE) {
#pragma unroll
                    for (int qq = 0; qq < 4; ++qq) xv += *(const f32x4*)(PQ + qq * 16384 + b * D + k); }
                if (gain) { float sr = dot4(xv);
#pragma unroll
                    for (int o = 1; o < 32; o <<= 1) sr += __shfl_xor(sr, o);
                    if ((lane & 31) == 0) ssqp[wave * 16 + b] = sr;
                    xv = xv * *(const f32x4*)(gain + k); }
                xst[(c4 + 0) * 16 + b] = xv.x; xst[(c4 + 1) * 16 + b] = xv.y; xst[(c4 + 2) * 16 + b] = xv.z; xst[(c4 + 3) * 16 + b] = xv.w;
            }
            asm volatile("s_waitcnt lgkmcnt(0)" ::: "memory");
            for (int kb = 0; kb < ksn; kb += 32) {
                float wn[32]; const bool more = (kb + 32 < ksn);
                if (more) {
#pragma unroll
                    for (int t = 0; t < 32; ++t) wn[t] = W[(size_t)(kbase + kb + 32 + t) * ldw + n0 + lane]; }
                else {
#pragma unroll
                    for (int t = 0; t < 32; ++t) wn[t] = 0.f; }
                __builtin_amdgcn_sched_barrier(0);
#pragma unroll
                for (int t = 0; t < 32; ++t) { const LAS f32x4* xp = (const LAS f32x4*)(xst + (kb + t) * 16);
                    const f32x4 x0 = xp[0], x1 = xp[1], x2 = xp[2], x3 = xp[3];
                    acc[0] = fmaf(x0.x, w[t], acc[0]); acc[1] = fmaf(x0.y, w[t], acc[1]); acc[2] = fmaf(x0.z, w[t], acc[2]); acc[3] = fmaf(x0.w, w[t], acc[3]);
                    acc[4] = fmaf(x1.x, w[t], acc[4]); acc[5] = fmaf(x1.y, w[t], acc[5]); acc[6] = fmaf(x1.z, w[t], acc[6]); acc[7] = fmaf(x1.w, w[t], acc[7]);
                    acc[8] = fmaf(x2.x, w[t], acc[8]); acc[9] = fmaf(x2.y, w[t], acc[9]); acc[10] = fmaf(x2.z, w[t], acc[10]); acc[11] = fmaf(x2.w, w[t], acc[11]);
                    acc[12] = fmaf(x3.x, w[t], acc[12]); acc[13] = fmaf(x3.y, w[t], acc[13]); acc[14] = fmaf(x3.z, w[t], acc[14]); acc[15] = fmaf(x3.w, w[t], acc[15]); }
#pragma unroll
                for (int t = 0; t < 32; ++t) w[t] = wn[t];
            }
            asm volatile("s_waitcnt lgkmcnt(0)" ::: "memory");
        }
#pragma unroll
        for (int b = 0; b < 16; ++b) part[(wave * 16 + b) * 64 + lane] = acc[b];
        __syncthreads();
#pragma unroll
        for (int rr = 0; rr < 2; ++rr) { const int b = 2 * wave + rr; float v = 0.f;
#pragma unroll
            for (int w2 = 0; w2 < 8; ++w2) v += part[(w2 * 16 + b) * 64 + lane];
            if (gain) { float sq = 0.f;
#pragma unroll
                for (int w2 = 0; w2 < 8; ++w2) sq += ssqp[w2 * 16 + b];
                v *= rsqrtf(sq * (1.f / D) + EPS); }
            const int n = n0 + lane;
            if (kind == SK_PROJ) SD[SD_PRJ + b * 6144 + n] = v;
            else if (kind == SK_W1) { const float r = fmaxf(v, 0.f); SD[SD_HS + b * FF + n] = r * r; }
            else if (kind == SK_UP) SD[SD_US + b * D + n] = v;
            else if (kind == SK_OUT) XSB[b * D + n] = XSA[b * D + n] + v;
            else if (kind == SK_W2) PQ[kq * 16384 + b * D + n] = v;
            else { float xm = XSB[b * D + n];
#pragma unroll
                for (int qq = 0; qq < 4; ++qq) xm += PQ[qq * 16384 + b * D + n];
                const float xn = fmaf(sigmoidf_(v), SD[SD_US + b * D + n], xm);
                XSA[b * D + n] = xn; const size_t row = (size_t)b * SEQ; a->out[row * D + n] = xn;
                ((bf16_t*)(a->ws + WS_XB))[row * D + n] = (bf16_t)(pk2(xn, 0.f) & 0xffffu);
                float ss = xn * xn;
#pragma unroll
                for (int o = 1; o < 64; o <<= 1) ss += __shfl_xor(ss, o);
                if (lane == 0) ((float*)(a->ws + (sv ? WS_SSP0 : WS_SSP1)))[row * 16 + it] = ss; }
        }
        __syncthreads();
    }
}
__device__ __forceinline__ void side_mixer(int i, float lam, int G) {
    KArgs a = kargs(); const int tid = opaque_tid(), lane = tid & 63, wave = __builtin_amdgcn_readfirstlane(tid >> 6), gw = opaque_bid() * NWAVES + wave;
    float* SD = (float*)(a->ws + WS_SIDE); const int j = i >> 1;
    if ((i & 1) == 0) { if (gw < NBATCH * 8) { const int b = gw >> 3, h = gw & 7; const float* vp = SD + SD_PRJ + b * 6144 + h * 128;
            const float o0 = (1.f - lam) * vp[lane], o1 = (1.f - lam) * vp[64 + lane]; float ss = o0 * o0 + o1 * o1;
#pragma unroll
            for (int o = 1; o < 64; o <<= 1) ss += __shfl_xor(ss, o);
            const float rn = rsqrtf(ss * (1.f / 128.f) + EPS) * (1.f - lambda_init_of(i)); const float* g = a->a_g_sub + j * 128;
            SD[SD_AV + b * 2048 + h * 128 + lane] = o0 * rn * g[lane]; SD[SD_AV + b * 2048 + h * 128 + 64 + lane] = o1 * rn * g[64 + lane]; } }
    else { if (gw < NBATCH * 4) { const int b = gw >> 2, h = gw & 3; const float* pp = SD + SD_PRJ + b * 6144; float w = 0.f;
#pragma unroll
            for (int t = 0; t < 4; ++t) w = fmaf(pp[h * 256 + 64 * t + lane], pp[1024 + h * 256 + 64 * t + lane], w);
#pragma unroll
            for (int o = 1; o < 64; o <<= 1) w += __shfl_xor(w, o);
            w *= 0.0625f; float ov[8]; float ss = 0.f;
#pragma unroll
            for (int t = 0; t < 8; ++t) { ov[t] = w * pp[2048 + h * 512 + 64 * t + lane]; ss = fmaf(ov[t], ov[t], ss); }
#pragma unroll
            for (int o = 1; o < 64; o <<= 1) ss += __shfl_xor(ss, o);
            const float rn = rsqrtf(ss * (1.f / 512.f) + EPS); const float* g = a->r_g_gn + j * 512;
#pragma unroll
            for (int t = 0; t < 8; ++t) { const float gt = pp[4096 + h * 512 + 64 * t + lane]; SD[SD_AV + b * 2048 + h * 512 + 64 * t + lane] = gt * sigmoidf_(gt) * ov[t] * rn * g[64 * t + lane]; } } }
}

#define XB_TMO      128
#define XB_XCNT(j)  (256  + 64 * (j))
#define XB_XSUB(j)  (1280 + 64 * (j))
#define XB_XGEN(j)  (2304 + 64 * (j))
#define XB_TOP      3328
#define XB_TOPGEN   3392
#define XCD_BAR_WORDS 3456
#define XB_SPIN_CAP (1u << 18)

__device__ __forceinline__ unsigned xb_ld(unsigned* p)              { return __hip_atomic_load(p, __ATOMIC_RELAXED, __HIP_MEMORY_SCOPE_AGENT); }
__device__ __forceinline__ unsigned xb_add(unsigned* p, unsigned v) { return __hip_atomic_fetch_add(p, v, __ATOMIC_RELAXED, __HIP_MEMORY_SCOPE_AGENT); }
__device__ __forceinline__ unsigned xb_xcc_id() { return (unsigned)__builtin_amdgcn_s_getreg((3 << 11) | 20) & 0xFu; }
#define XB_SPIN(cond, bar) do { unsigned _sp = 0; while (cond) { __builtin_amdgcn_s_sleep(1); \
    if ((++_sp & 255u) == 0u) { if (xb_ld(&(bar)[XB_TMO])) break; if (_sp > XB_SPIN_CAP) { atomicAdd(&(bar)[XB_TMO], 1u); break; } } } } while (0)

struct XcdBarrier {
    unsigned* bar; unsigned x;
    volatile LAS unsigned* st;
};

__device__ __forceinline__ XcdBarrier xcd_barrier_post(unsigned* bar, volatile LAS unsigned* st) {
    XcdBarrier b; b.bar = bar; b.x = xb_xcc_id(); b.st = st;
    if (threadIdx.x == 0) (void)xb_add(&bar[XB_XCNT(b.x)], 1u);
    return b;
}
__device__ __forceinline__ void xcd_barrier_complete(unsigned* bar, unsigned x, unsigned& nloc, unsigned& nx) {
    const unsigned G = gridDim.x * gridDim.y * gridDim.z;
    unsigned sum, cnt, mine, sp = 0u;
    for (;;) {
        sum = 0u; cnt = 0u; mine = 0u;
#pragma unroll
        for (unsigned j = 0; j < 16; ++j) { const unsigned c = xb_ld(&bar[XB_XCNT(j)]); sum += c; cnt += (c > 0u) ? 1u : 0u; mine = (j == x) ? c : mine; }
        if (sum == G) break;
        __builtin_amdgcn_s_sleep(1);
        if ((++sp & 255u) == 0u) { if (xb_ld(&bar[XB_TMO])) break; if (sp > XB_SPIN_CAP) { atomicAdd(&bar[XB_TMO], 1u); break; } }
    }
    nloc = mine > 0u ? mine : 1u; nx = cnt > 0u ? cnt : 1u;
}

__device__ __forceinline__ void xcd_barrier(const XcdBarrier& b) {
    asm volatile("s_waitcnt vmcnt(0)" ::: "memory");
    __syncthreads();
    if (threadIdx.x == 0) {
        unsigned* bar = b.bar;
        __builtin_amdgcn_s_waitcnt(0);
        unsigned nloc = b.st[0], nx = b.st[1];
        if (nloc == 0u) { xcd_barrier_complete(bar, b.x, nloc, nx); b.st[0] = nloc; b.st[1] = nx; }
        const unsigned old = xb_add(&bar[XB_XSUB(b.x)], 1u);
        const unsigned gen = old / nloc;
        if (old + 1u == (gen + 1u) * nloc) {
            __builtin_amdgcn_fence(__ATOMIC_RELEASE, "agent");
            asm volatile("s_waitcnt vmcnt(0)" ::: "memory");
            const unsigned og = xb_add(&bar[XB_TOP], 1u);
            const unsigned tg = og / nx;
            if (og + 1u == (tg + 1u) * nx) xb_add(&bar[XB_TOPGEN], 1u);
            else XB_SPIN(xb_ld(&bar[XB_TOPGEN]) == tg, bar);
            __builtin_amdgcn_fence(__ATOMIC_ACQUIRE, "agent");
            xb_add(&bar[XB_XGEN(b.x)], 1u);
            asm volatile("s_waitcnt vmcnt(0)" ::: "memory");
        } else {
            XB_SPIN(xb_ld(&bar[XB_XGEN(b.x)]) == gen, bar);
            __builtin_amdgcn_fence(__ATOMIC_ACQUIRE, "agent");
            asm volatile("s_waitcnt vmcnt(0)" ::: "memory");
        }
    }
    __syncthreads();
}

constexpr size_t WS_BAR = WS_SIDE + 960 * 1024;

#define GSYNC() do { XcdBarrier b_; b_.bar = (unsigned*)(kargs()->ws + WS_BAR); b_.x = xb_xcc_id(); b_.st = (volatile LAS unsigned*)(lds + 147440); xcd_barrier(b_); } while (0)
__global__ void __launch_bounds__(NWAVES * 64, 2) fwd_mega(Args a) {
    extern __shared__ __attribute__((aligned(16))) unsigned char lds_raw[];
    LAS unsigned char* lds = (LAS unsigned char*)lds_raw;
    const int G = gridDim.x;
    unsigned char* ws = kargs()->ws;
    volatile LAS unsigned* xst = (volatile LAS unsigned*)(lds + 147440);
    if (threadIdx.x < 4) xst[threadIdx.x] = 0u;
    __syncthreads();
    { cg::grid_group grid = cg::this_grid(); if (kargs()->ws == nullptr) grid.sync(); }
    (void)xcd_barrier_post((unsigned*)(ws + WS_BAR), xst);
    bf16_t* XB = (bf16_t*)(ws + WS_XB); bf16_t* PB = (bf16_t*)(ws + WS_PB);
    bf16_t* T0 = (bf16_t*)(ws + WS_T);
    bf16_t* W_IN = (bf16_t*)(ws + WS_WIN); bf16_t* W_OUT = (bf16_t*)(ws + WS_WOUT); bf16_t* W_1 = (bf16_t*)(ws + WS_W1); bf16_t* W_2 = (bf16_t*)(ws + WS_W2);
    bf16_t* W_UP = (bf16_t*)(ws + WS_WUP); bf16_t* W_GATE = (bf16_t*)(ws + WS_WGATE);
    float* SSO = (float*)(ws + WS_SSO);
    const size_t E64 = (size_t)32 * MiB;

    prologue_rows(G);
    convert_in(0, lds, G);
    GSYNC();

    int sv = 0;
#ifdef PROBE_T
    LAS unsigned long long* TA = (LAS unsigned long long*)(lds + 146432);
    if (threadIdx.x == 0) { for (int q = 0; q < 8; ++q) TA[q] = 0ull; }
#define TSTAMP() __builtin_amdgcn_s_memrealtime()
#define TADD(c, t0) do { if (threadIdx.x == 0) TA[c] += TSTAMP() - (t0); } while (0)
#else
#define TSTAMP() 0ull
#define TADD(c, t0) do { (void)(t0); } while (0)
#endif
    for (int i = 0; i < 4; ++i) {
        const bool attn = (i & 1) == 0; const int j = i >> 1;
        for (int slot = 0; slot < 11; ++slot) {
            int sk = -1;
            int kind = 0;
            bool sync = false, flip = false;
            const bf16_t* gA = nullptr; const bf16_t* gB = nullptr; int gM = 0, gN = 0, gK = 0;
            EpiG E; E.mode = 0; E.layer = i; E.sv = sv; E.xbalt = 0; E.ret = 0; E.x0src = 0; E.nobf = 0; E.pad2_ = 0; E.ws = ws;
            if (slot == 0) { kind = 4; }
            else if (slot == 1) { kind = 1; sk = SK_PROJ; gA = XB; gB = W_IN; gM = M; gK = D;
                if (attn) { gN = 2048; E.mode = MODE_ATTN_QK; } else { gN = 4096; E.mode = MODE_RET_QKG; } }
            else if (slot == 2) { kind = 1; sync = true; gB = XB; gN = M; gK = D; E.mode = MODE_VT;
                if (attn) { gA = W_IN + (size_t)2048 * D; gM = 1024; } else { gA = W_IN + (size_t)4096 * D; gM = 2048; E.ret = 1; } }
            else if (slot == 3) { kind = 2; sync = true; }
            else if (slot == 4) { if (!attn) { kind = 3; sync = true; } }
            else if (slot == 5) { kind = 1; sk = SK_OUT; sync = true; flip = true; gB = W_OUT; gM = M; gN = D; E.mode = MODE_RESID; E.x0src = (i == 0);
                if (attn) { gA = T0 + 3 * E64; gK = 1024; } else { gA = T0 + 4 * E64; gK = 2048; } }
            else if (slot == 6) { kind = 1; sk = SK_W1; gA = XB; gB = W_1; gM = M; gN = FF; gK = D; E.mode = MODE_SQRELU; }
            else if (slot == 7) { kind = 1; sync = true; gA = PB; gB = W_UP; gM = M; gN = D; gK = PLE; E.mode = MODE_PLAIN; }
            else if (slot == 8) { kind = 1; sk = SK_W2; sync = true; flip = true; gA = T0; gB = W_2; gM = M; gN = D; gK = FF; E.mode = MODE_RESID; E.xbalt = 1; }
            else if (slot == 9) { if (i < 3) kind = 5; }
            else { kind = 1; sk = SK_GATE; sync = (i < 3); flip = true; gA = T0 + 5 * E64; gB = W_GATE; gM = M; gN = D; gK = D; E.mode = MODE_GATE; E.nobf = (i == 3); }

            const unsigned long long ts0 = TSTAMP();
            if (kind == 1) {
                __syncthreads();
                if (sk >= 0) { side_step(sk, i, sv, lds, G); if (sk == SK_PROJ) side_step(SK_UP, i, sv, lds, G, 128); TADD(5, ts0); }
                __syncthreads();
                pg8::Gemm g{gA, gB, gM, gN, gK}; pg8::StaticOrder S; S.init(gM, gN, G, opaque_bid());
#ifndef NO_GEMM
                pg8::gemm_phase<EpiG, pg8::StaticOrder, GEMM_ALIGN, GEMM_SP2>(lds, g, S, E);
#endif
            } else if (kind == 2) {
                __syncthreads();
                if (attn) {
                    const int lane = opaque_tid() & 63;
                    KArgs ka = kargs();
                    float d1 = ka->a_lq1[j * 64 + lane] * ka->a_lk1[j * 64 + lane], d2 = ka->a_lq2[j * 64 + lane] * ka->a_lk2[j * 64 + lane];
#pragma unroll
                    for (int o = 1; o < 64; o <<= 1) { d1 += __shfl_xor(d1, o); d2 += __shfl_xor(d2, o); }
                    const float lam = expf(d1) - expf(d2) + lambda_init_of(i);
                    side_mixer(i, lam, G);
#if defined(NAIVE_ATTN)
                    attn_naive(T0, T0 + E64, T0 + 2 * E64, T0 + 3 * E64, lam, G);
#elif !defined(NO_ATTN)
#ifdef ATTN_V1
                    attn_phase(lds, T0, T0 + E64, T0 + 2 * E64, T0 + 3 * E64, lam, G);
#else
                    attn_phase2(lds, T0, T0 + E64, T0 + 2 * E64, T0 + 3 * E64, lam, G);
#endif
#endif
                } else {
                    side_mixer(i, 0.f, G);
#if defined(NAIVE_RET)
                    ret_naive(T0, T0 + E64, T0 + 2 * E64, T0 + 4 * E64, SSO, G);
#elif !defined(NO_RET)
                    ret_phase(lds, T0, T0 + E64, T0 + 2 * E64, T0 + 4 * E64, SSO, G);
#endif
                }
            } else if (kind == 3) {
                ret_norm_phase(T0 + 4 * E64, SSO, G);
            } else if (kind == 4) {
                __syncthreads();
                convert_rest(i, lds, G);
            } else if (kind == 5) {
                __syncthreads();
                convert_in(i + 1, lds, G);
            }
            if (flip) sv ^= 1;
            const unsigned long long ts1 = TSTAMP();
            if (sync) { GSYNC(); TADD(3, ts1); }
            TADD((kind == 2 ? (attn ? 1 : 2) : kind == 3 ? 2 : (kind == 4 || kind == 5) ? 4 : 0), ts0);
        }
    }
#ifdef PROBE_T
    if (blockIdx.x == 0 && threadIdx.x == 0) kargs()->out[0] = (float)TA[PROBE_T] * 10.f;
#endif
}

extern "C" void kernel_launch(void* const* d_in, const int* in_sizes, int n_in, void* d_out, int out_size, void* d_ws, size_t ws_size, hipStream_t stream) {
    static int grid = 0;
    if (grid == 0) {
        if (n_in != 21 || out_size != M * D || ws_size < WS_END) { fprintf(stderr, "kernel_launch: unexpected shapes (n_in %d, out %d, ws %zu)\n", n_in, out_size, ws_size); grid = -1; return; }
        int dev = 0, cus = 0, per_cu = 0;
        hipGetDevice(&dev); hipDeviceGetAttribute(&cus, hipDeviceAttributeMultiprocessorCount, dev);
        hipFuncSetAttribute((const void*)fwd_mega, hipFuncAttributeMaxDynamicSharedMemorySize, LDS_BYTES);
        hipOccupancyMaxActiveBlocksPerMultiprocessor(&per_cu, (const void*)fwd_mega, NWAVES * 64, LDS_BYTES);
        if (per_cu < 1) per_cu = 1;
        grid = cus * per_cu;
        if (grid > 256) grid = 256;
        (void)hipGetLastError();
    }
    if (grid < 0) return;
    Args a{};
    a.x = (const float*)d_in[0]; a.p = (const float*)d_in[1]; a.norm_mix = (const float*)d_in[2]; a.norm_mlp = (const float*)d_in[3]; a.norm_pe = (const float*)d_in[4];
    a.a_w_qkv = (const float*)d_in[5]; a.a_w_o = (const float*)d_in[6]; a.a_g_q = (const float*)d_in[7]; a.a_g_k = (const float*)d_in[8];
    a.a_lq1 = (const float*)d_in[9]; a.a_lk1 = (const float*)d_in[10]; a.a_lq2 = (const float*)d_in[11]; a.a_lk2 = (const float*)d_in[12]; a.a_g_sub = (const float*)d_in[13];
    a.r_w_in = (const float*)d_in[14]; a.r_w_out = (const float*)d_in[15]; a.r_g_gn = (const float*)d_in[16]; a.mlp_w1 = (const float*)d_in[17]; a.mlp_w2 = (const float*)d_in[18];
    a.pe_w_up = (const float*)d_in[19]; a.pe_w_gate = (const float*)d_in[20];
    a.out = (float*)d_out; a.ws = (unsigned char*)d_ws;
    (void)hipMemsetAsync((unsigned char*)d_ws + WS_BAR, 0, XCD_BAR_WORDS * sizeof(unsigned), stream);
    void* args[] = {&a};
    hipError_t e = hipLaunchCooperativeKernel((const void*)fwd_mega, dim3(grid), dim3(NWAVES * 64), args, LDS_BYTES, stream);
    if (e != hipSuccess) fprintf(stderr, "cooperative launch failed: %s (grid %d)\n", hipGetErrorString(e), grid);
}
```

```cpp
#include <hip/hip_runtime.h>
#include <hip/hip_cooperative_groups.h>
#include <cstdio>
#include <cstdint>
namespace cg = cooperative_groups;
#ifndef GEMM_ALIGN
#define GEMM_ALIGN true
#define GEMM_SP2 true
#endif
namespace pg8 {
#define PG8_LAS __attribute__((address_space(3)))
typedef unsigned short bf16_t;
typedef short bf16x8 __attribute__((ext_vector_type(8)));
typedef float f32x4 __attribute__((ext_vector_type(4)));
typedef unsigned u32x4 __attribute__((ext_vector_type(4)));
constexpr int BM = 256, BK = 64, HALF = 128, HTB = HALF * BK * 2  , STAGE_BYTES = 8 * HTB, NXCD = 8, WGM = 4;

__host__ __device__ __forceinline__ int lds_byte(int r, int c) { const int st = (r >> 4) * 2 + (c >> 5), rr = r & 15, cc = c & 31, ob = rr * 64 + cc * 2; return st * 1024 + (ob ^ (((ob >> 9) & 1) << 5)); }
__host__ __device__ __forceinline__ void stage_rc(int b, int& R, int& C) { const int st = b / 1024, sb = b % 1024, swz = sb ^ (((sb >> 9) & 1) << 5); R = (st >> 1) * 16 + swz / 64; C = (st & 1) * 32 + (swz % 64) / 2; }
__host__ __device__ __forceinline__ int perm32(int rho) { const int n = rho >> 4, i = rho & 15; return 8 * (i >> 2) + 4 * n + (i & 3); }

struct Unit { int pm, pn; };
struct Gemm { const bf16_t* A; const bf16_t* Bt; int M, N, K; };

struct StaticOrder {
    int nM, nN, nwg, G, c;
    __host__ __device__ void init(int M, int N, int G_, int c_) { nM = M / BM; nN = N / BM; nwg = nM * nN; G = G_; c = c_; }
    __host__ __device__ bool next(int i, Unit& u) const {
        const long L = (long)i * G + c; if (L >= nwg) return false;
        int wgid = (int)L; { const int q = nwg / NXCD, r = nwg % NXCD, xcd = wgid % NXCD, off = wgid / NXCD; wgid = (xcd < r ? xcd * (q + 1) : r * (q + 1) + (xcd - r) * q) + off; }
        const int nig = WGM * nN, gid = wgid / nig, fm = gid * WGM, gsz = (nM - fm) < WGM ? (nM - fm) : WGM;
        u.pm = fm + ((wgid % nig) % gsz); u.pn = (wgid % nig) / gsz; return true;
    }
    __device__ __forceinline__ void a_ready(const Unit&) const {}
    __device__ __forceinline__ void done(const Unit&) const {}
};

__device__ __forceinline__ unsigned cvt_pk_bf16(float lo, float hi) { unsigned r; asm volatile("v_cvt_pk_bf16_f32 %0, %1, %2" : "=v"(r) : "v"(lo), "v"(hi)); return r; }
typedef float f32x2 __attribute__((ext_vector_type(2)));
template <class Epi, class Sched, bool ALIGN_EPI = false, bool SP2 = false>
__device__ __forceinline__ void gemm_phase(PG8_LAS unsigned char* lds, const Gemm g, const Sched& S, const Epi& E) {
    int tid = threadIdx.x; asm volatile("" : "+v"(tid)); const int wid = __builtin_amdgcn_readfirstlane(tid >> 6), lane = tid & 63, wr = wid >> 2, wc = wid & 3, fr = lane & 15, fq = lane >> 4;
    const int K = g.K, nt = K / BK;
    unsigned voffA, voffB;
    { int R, C; stage_rc(tid * 16, R, C); const int Rb = Epi::PERM ? ((R & ~31) + perm32(R & 31)) : R;
        voffA = (unsigned)(R * K + C) * 2u; voffB = (unsigned)(Rb * K + C) * 2u; }
    const size_t pstep = (size_t)128 * K;
    const size_t kstep = (size_t)(BK * 2);
    const size_t hstep = (size_t)HALF * K * 2;
    const size_t tstep = 2 * hstep;
    const unsigned ldsw = (unsigned)wid * 1024u;
    const int aoff = lds_byte(wr * 64 + fr, fq * 8), boff = lds_byte(wc * 32 + fr, fq * 8);
#define PG8_SA(b, h) (((b) * 2 + (h)) * HTB)
#define PG8_SB(b, h) ((4 + (b) * 2 + (h)) * HTB)
#define PG8_STAGE(bufoff, gbase, voff) do { _Pragma("unroll") for (int _i = 0; _i < 2; ++_i) \
        __builtin_amdgcn_global_load_lds((const unsigned*)((const char*)(gbase) + _i * pstep + (voff)), (PG8_LAS unsigned*)(lds + (bufoff) + ldsw + _i * 8192), 16, 0, 0); } while (0)
#define PG8_LDA(dst, b, h) do { _Pragma("unroll") for (int m = 0; m < 4; ++m) _Pragma("unroll") for (int k = 0; k < 2; ++k) dst[m][k] = *(const PG8_LAS bf16x8*)(lds + PG8_SA(b, h) + aoff + m * 2048 + k * 1024); } while (0)
#define PG8_LDB(dst, b, h) do { _Pragma("unroll") for (int n = 0; n < 2; ++n) _Pragma("unroll") for (int k = 0; k < 2; ++k) dst[n][k] = *(const PG8_LAS bf16x8*)(lds + PG8_SB(b, h) + boff + n * 2048 + k * 1024); } while (0)
#define PG8_MMA(ai, bj, At, Bt) do { __builtin_amdgcn_s_setprio(1); _Pragma("unroll") for (int m = 0; m < 4; ++m) _Pragma("unroll") for (int n = 0; n < 2; ++n) _Pragma("unroll") for (int k = 0; k < 2; ++k) \
        acc[ai][bj][m][n] = __builtin_amdgcn_mfma_f32_16x16x32_bf16(Bt[n][k], At[m][k], acc[ai][bj][m][n], 0, 0, 0); __builtin_amdgcn_s_setprio(0); } while (0)
#define PG8_WAIT_V(n) asm volatile("s_waitcnt vmcnt(" #n ")" ::: "memory")
#define PG8_WAIT_L(n) asm volatile("s_waitcnt lgkmcnt(" #n ")" ::: "memory")
#define PG8_BAR __builtin_amdgcn_s_barrier()
#define PG8_SCHED __builtin_amdgcn_sched_barrier(0)
    Unit cur, nxt; int ui = 0;
    if (!S.next(0, cur)) return;
    f32x4 acc[2][2][4][2];
#pragma unroll
    for (int a = 0; a < 2; ++a)
#pragma unroll
        for (int b = 0; b < 2; ++b)
#pragma unroll
            for (int m = 0; m < 4; ++m)
#pragma unroll
                for (int n = 0; n < 2; ++n) acc[a][b][m][n] = (f32x4){0.f, 0.f, 0.f, 0.f};
    bf16x8 At[4][2], B0[2][2], B1[2][2];
    const char* cA = (const char*)g.A + (size_t)cur.pm * tstep; const char* cB = (const char*)g.Bt + (size_t)cur.pn * tstep;
    S.a_ready(cur);
    if constexpr (SP2) {
        PG8_STAGE(PG8_SB(0, 0), cB, voffB); PG8_STAGE(PG8_SB(0, 1), cB + hstep, voffB); PG8_STAGE(PG8_SA(0, 0), cA, voffA); PG8_STAGE(PG8_SA(0, 1), cA + hstep, voffA);
        if (wr == 1) PG8_BAR;
        PG8_WAIT_V(2); PG8_BAR;
        PG8_STAGE(PG8_SB(1, 0), cB + kstep, voffB); PG8_STAGE(PG8_SA(1, 0), cA + kstep, voffA); PG8_STAGE(PG8_SB(1, 1), cB + hstep + kstep, voffB);
        PG8_WAIT_V(6); PG8_BAR;
    } else {
        PG8_STAGE(PG8_SB(0, 0), cB, voffB); PG8_STAGE(PG8_SA(0, 0), cA, voffA); PG8_STAGE(PG8_SB(0, 1), cB + hstep, voffB); PG8_STAGE(PG8_SA(0, 1), cA + hstep, voffA);
        if (wr == 1) PG8_BAR;
        PG8_WAIT_V(4); PG8_BAR;
        PG8_STAGE(PG8_SB(1, 0), cB + kstep, voffB); PG8_STAGE(PG8_SA(1, 0), cA + kstep, voffA); PG8_STAGE(PG8_SB(1, 1), cB + hstep + kstep, voffB);
        PG8_WAIT_V(6); PG8_BAR;
    }
    for (;;) {
        const bool has_next = S.next(ui + 1, nxt);
        const char* nA = has_next ? (const char*)g.A + (size_t)nxt.pm * tstep : cA; const char* nB = has_next ? (const char*)g.Bt + (size_t)nxt.pn * tstep : cB;
        for (int t = 0; t < nt; t += 2) {
            const bool last = (t == nt - 2);
            const char* a1 = cA + (size_t)(t + 1) * kstep;
            const char* a2 = last ? nA : cA + (size_t)(t + 2) * kstep; const char* b2 = last ? nB : cB + (size_t)(t + 2) * kstep;
            const char* a3 = a2 + kstep; const char* b3 = b2 + kstep;
            if (last && has_next) S.a_ready(nxt);
            if constexpr (SP2) {
            PG8_LDB(B0, 0, 0); PG8_LDB(B1, 0, 1); PG8_SCHED; PG8_LDA(At, 0, 0); PG8_STAGE(PG8_SA(1, 1), a1 + hstep, voffA);
            PG8_WAIT_V(8); PG8_WAIT_L(0); PG8_BAR; PG8_MMA(0, 0, At, B0); PG8_MMA(0, 1, At, B1); PG8_BAR; PG8_SCHED;
            PG8_LDA(At, 0, 1); PG8_STAGE(PG8_SB(0, 0), b2, voffB); PG8_STAGE(PG8_SB(0, 1), b2 + hstep, voffB); PG8_STAGE(PG8_SA(0, 0), a2, voffA);
            PG8_WAIT_V(8); PG8_WAIT_L(0); PG8_BAR; PG8_MMA(1, 0, At, B0); PG8_MMA(1, 1, At, B1); PG8_BAR; PG8_SCHED;
            PG8_LDB(B0, 1, 0); PG8_LDB(B1, 1, 1); PG8_SCHED; PG8_LDA(At, 1, 0); PG8_STAGE(PG8_SA(0, 1), a2 + hstep, voffA);
            PG8_WAIT_V(8); PG8_WAIT_L(0); PG8_BAR; PG8_MMA(0, 0, At, B0); PG8_MMA(0, 1, At, B1); PG8_BAR; PG8_SCHED;
            PG8_LDA(At, 1, 1); PG8_STAGE(PG8_SB(1, 0), b3, voffB); PG8_STAGE(PG8_SB(1, 1), b3 + hstep, voffB); PG8_STAGE(PG8_SA(1, 0), a3, voffA);
            PG8_WAIT_V(8); PG8_WAIT_L(0); PG8_BAR; PG8_MMA(1, 0, At, B0); PG8_MMA(1, 1, At, B1); PG8_BAR; PG8_SCHED;
            } else {
            PG8_LDB(B0, 0, 0); PG8_SCHED; PG8_LDA(At, 0, 0); PG8_STAGE(PG8_SA(1, 1), a1 + hstep, voffA);
            PG8_WAIT_L(8); PG8_BAR; PG8_WAIT_L(0); PG8_MMA(0, 0, At, B0); PG8_BAR; PG8_SCHED;
            PG8_LDB(B1, 0, 1); PG8_STAGE(PG8_SB(0, 0), b2, voffB);
            PG8_BAR; PG8_WAIT_L(0); PG8_MMA(0, 1, At, B1); PG8_BAR;
            PG8_LDA(At, 0, 1); PG8_STAGE(PG8_SA(0, 0), a2, voffA);
            PG8_BAR; PG8_WAIT_L(0); PG8_MMA(1, 0, At, B0); PG8_BAR; PG8_SCHED;
            PG8_STAGE(PG8_SB(0, 1), b2 + hstep, voffB);
            PG8_WAIT_V(6); PG8_BAR; PG8_MMA(1, 1, At, B1); PG8_BAR;
            PG8_LDB(B0, 1, 0); PG8_SCHED; PG8_LDA(At, 1, 0); PG8_STAGE(PG8_SA(0, 1), a2 + hstep, voffA);
            PG8_WAIT_L(8); PG8_BAR; PG8_WAIT_L(0); PG8_MMA(0, 0, At, B0); PG8_BAR; PG8_SCHED;
            PG8_LDB(B1, 1, 1); PG8_STAGE(PG8_SB(1, 0), b3, voffB);
            PG8_BAR; PG8_WAIT_L(0); PG8_MMA(0, 1, At, B1); PG8_BAR;
            PG8_LDA(At, 1, 1); PG8_STAGE(PG8_SA(1, 0), a3, voffA);
            PG8_BAR; PG8_WAIT_L(0); PG8_MMA(1, 0, At, B0); PG8_BAR; PG8_SCHED;
            PG8_STAGE(PG8_SB(1, 1), b3 + hstep, voffB);
            PG8_WAIT_V(6); PG8_BAR; PG8_MMA(1, 1, At, B1); PG8_BAR;
            }
        }
        if constexpr (ALIGN_EPI) { if (wr == 0) PG8_BAR; }
        if constexpr (!Epi::AFTER_DRAIN) { E(acc, cur, wr, wc, fr, fq); S.done(cur); }
        if (!has_next) break;
#pragma unroll
        for (int a = 0; a < 2; ++a)
#pragma unroll
            for (int b = 0; b < 2; ++b)
#pragma unroll
                for (int m = 0; m < 4; ++m)
#pragma unroll
                    for (int n = 0; n < 2; ++n) acc[a][b][m][n] = (f32x4){0.f, 0.f, 0.f, 0.f};
        cur = nxt; cA = nA; cB = nB; ++ui;
        if constexpr (ALIGN_EPI) { if (wr == 1) PG8_BAR; }
    }
    PG8_WAIT_V(0);
    if constexpr (!ALIGN_EPI) { if (wr == 0) PG8_BAR; }
    PG8_BAR;
    if constexpr (Epi::AFTER_DRAIN) { E.fused(acc, cur, wr, wc, fr, fq, lds, wid, lane); S.done(cur); }
#undef PG8_SA
#undef PG8_SB
#undef PG8_STAGE
#undef PG8_LDA
#undef PG8_LDB
#undef PG8_MMA
#undef PG8_WAIT_V
#undef PG8_WAIT_L
#undef PG8_BAR
#undef PG8_SCHED
}
}

using pg8::bf16_t; using pg8::bf16x8; using pg8::f32x4; using pg8::u32x4;
typedef float f32x16 __attribute__((ext_vector_type(16)));
typedef unsigned u32x2 __attribute__((ext_vector_type(2)));
typedef short s16x4 __attribute__((ext_vector_type(4)));
#define LAS __attribute__((address_space(3)))
constexpr int D = 1024, NBATCH = 16, SEQ = 2048, M = NBATCH * SEQ, FF = 4096, PLE = 256, NWAVES = 8;
constexpr float EPS = 1e-6f, LOG2E = 1.4426950408889634f;
constexpr size_t MiB = 1u << 20;
constexpr size_t WS_SSP0 = 0, WS_SSO = 2 * MiB, WS_WIN = 10 * MiB, WS_WOUT = 22 * MiB, WS_W1 = 26 * MiB, WS_W2 = 34 * MiB, WS_WUP = 42 * MiB, WS_WGATE = 42 * MiB + 512 * 1024,
                 WS_QK0 = 44 * MiB + 512 * 1024, WS_XB = 45 * MiB, WS_PB = 109 * MiB, WS_T = 125 * MiB, WS_SSP1 = 509 * MiB, WS_SIDE = 511 * MiB, WS_END = 512 * MiB;
constexpr int SD_XS = 0, SD_PRJ = 32768, SD_AV = 131072, SD_HS = 163840, SD_US = 229376;
constexpr int LDS_BYTES = 147456;

__device__ __forceinline__ int opaque_tid() { int t = threadIdx.x; asm volatile("" : "+v"(t)); return t; }
__device__ __forceinline__ int opaque_bid() { int t = blockIdx.x; asm volatile("" : "+s"(t)); return t; }
typedef float f32x2_t __attribute__((ext_vector_type(2))); typedef __bf16 bf16x2_t __attribute__((ext_vector_type(2)));
__device__ __forceinline__ unsigned pk2(float lo, float hi) { f32x2_t v = {lo, hi}; bf16x2_t b = __builtin_convertvector(v, bf16x2_t); return __builtin_bit_cast(unsigned, b); }
__device__ __forceinline__ float bf_lo(unsigned w) { return __uint_as_float(w << 16); }
__device__ __forceinline__ float bf_hi(unsigned w) { return __uint_as_float(w & 0xffff0000u); }
__device__ __forceinline__ float fexp2(float x) { return __builtin_amdgcn_exp2f(x); }
__device__ __forceinline__ float sigmoidf_(float z) { return __builtin_amdgcn_rcpf(1.f + fexp2(-z * LOG2E)); }
__device__ __forceinline__ float dot4(f32x4 v) { return (v.x * v.x + v.y * v.y) + (v.z * v.z + v.w * v.w); }
__device__ __forceinline__ float sum4(f32x4 v) { return (v.x + v.y) + (v.z + v.w); }
__device__ __forceinline__ u32x4 pack8(f32x4 a, f32x4 b) { u32x4 w; w.x = pk2(a.x, a.y); w.y = pk2(a.z, a.w); w.z = pk2(b.x, b.y); w.w = pk2(b.z, b.w); return w; }

struct Args {
    const float *x, *p, *norm_mix, *norm_mlp, *norm_pe, *a_w_qkv, *a_w_o, *a_g_q, *a_g_k, *a_lq1, *a_lk1, *a_lq2, *a_lk2, *a_g_sub, *r_w_in, *r_w_out, *r_g_gn, *mlp_w1, *mlp_w2, *pe_w_up, *pe_w_gate;
    float* out; unsigned char* ws;
};

typedef const __attribute__((address_space(4))) Args* KArgs;
__device__ __forceinline__ KArgs kargs() { KArgs p = (KArgs)__builtin_amdgcn_kernarg_segment_ptr(); asm volatile("" : "+s"(p)); return p; }
enum { MODE_PLAIN = 0, MODE_ATTN_QK = 1, MODE_RET_QKG = 2, MODE_SQRELU = 3, MODE_RESID = 4, MODE_GATE = 5, MODE_VT = 6 };
struct EpiG {
    static constexpr bool PERM = true, AFTER_DRAIN = false;
    int mode, layer, sv, xbalt, ret, x0src, nobf;
    int pad2_;
    unsigned char* ws;
    __device__ __forceinline__ void operator()(const f32x4 (&acc)[2][2][4][2], const pg8::Unit& u, int wr_, int wc_, int fr_, int fq_) const {
        const int t2 = opaque_tid(); const int lane = t2 & 63, fr = lane & 15, fq = lane >> 4, wv_ = __builtin_amdgcn_readfirstlane(t2 >> 6), wr = wv_ >> 2, wc = wv_ & 3;
        (void)wr_; (void)wc_; (void)fr_; (void)fq_;
        const float* ssp = (const float*)(ws + (sv ? WS_SSP1 : WS_SSP0)); float* sspw = (float*)(ws + (sv ? WS_SSP0 : WS_SSP1));
        bf16_t* T0 = (bf16_t*)(ws + WS_T); const size_t E64 = (size_t)32 * MiB;
        bf16_t* o0 = T0; bf16_t* o1 = T0 + E64; bf16_t* o2 = T0 + 4 * E64; int ld0 = D;
        if (mode == MODE_VT) { o0 = T0 + 2 * E64; ld0 = M; } else if (mode == MODE_SQRELU) { ld0 = FF; } else if (mode == MODE_PLAIN) { o0 = T0 + 4 * E64; }
        if (mode == MODE_VT) {
            const int tokL = u.pn * 256 + (lane >> 5) * 128 + wc * 32 + (lane & 31);
            const f32x4* sp = (const f32x4*)(ssp + (size_t)tokL * 16);
            const f32x4 a = sp[0], b = sp[1], c = sp[2], d = sp[3];
            const float s = (sum4(a) + sum4(b)) + (sum4(c) + sum4(d));
            const float rsL = rsqrtf(s * (1.f / 1024.f) + EPS);
            float l2g = 0.f; if (ret) { const int h = u.pm >> 1; l2g = log2f(1.f - fexp2(-5.f - (float)h)); }
#pragma unroll
            for (int bj = 0; bj < 2; ++bj) {
                bf16_t* vbase = T0 + 2 * E64 + (size_t)(u.pm * 256 + wr * 64 + fr) * M + u.pn * 256 + wc * 32 + 8 * fq + bj * 128;
                f32x4 cs[2];
#pragma unroll
                for (int n = 0; n < 2; ++n)
#pragma unroll
                    for (int x = 0; x < 4; ++x) { float v = __shfl(rsL, 32 * bj + 8 * fq + 4 * n + x); if (ret) v *= fexp2(l2g * (float)(127 - (32 * wc + 8 * fq + 4 * n + x))); cs[n][x] = v; }
#pragma unroll
                for (int ai = 0; ai < 2; ++ai)
#pragma unroll
                    for (int m = 0; m < 4; ++m) { bf16_t* rowp = vbase + (size_t)(ai * 128 + m * 16) * M;
                        *(u32x4*)(rowp) = pack8(acc[ai][bj][m][0] * cs[0], acc[ai][bj][m][1] * cs[1]); }
                asm volatile("" ::: "memory");
            }
            return;
        }
        const int row0 = u.pm * 256 + wr * 64 + fr;
        float rs[2][4];
        if (mode != MODE_PLAIN && mode != MODE_RESID) {
            f32x4 sv4[2][4];
#pragma unroll
            for (int ai = 0; ai < 2; ++ai)
#pragma unroll
                for (int m = 0; m < 4; ++m) sv4[ai][m] = *(const f32x4*)(ssp + (size_t)(row0 + ai * 128 + m * 16) * 16 + 4 * fq);
            __builtin_amdgcn_sched_barrier(0);
#pragma unroll
            for (int ai = 0; ai < 2; ++ai)
#pragma unroll
                for (int m = 0; m < 4; ++m) { float s = sum4(sv4[ai][m]); s += __shfl_xor(s, 16); s += __shfl_xor(s, 32); rs[ai][m] = rsqrtf(s * (1.f / 1024.f) + EPS); }
        } else {
#pragma unroll
            for (int ai = 0; ai < 2; ++ai)
#pragma unroll
                for (int m = 0; m < 4; ++m) rs[ai][m] = 1.f;
        }
        if (mode == MODE_RESID || mode == MODE_GATE) {
            float* X = kargs()->out; const float* Xr = x0src ? kargs()->x : (const float*)X; const bf16_t* U = T0 + 4 * E64; bf16_t* XBw = xbalt ? (T0 + 5 * E64) : (bf16_t*)(ws + WS_XB);
#pragma unroll
            for (int am = 0; am < 4; ++am) { const int ai = am >> 1, m0 = (am & 1) * 2;
                f32x4 xa[4][2][2]; u32x4 ua[4][2];
#pragma unroll
                for (int m = m0; m < m0 + 2; ++m)
#pragma unroll
                    for (int bj = 0; bj < 2; ++bj) { const int row = row0 + ai * 128 + m * 16, col0 = u.pn * 256 + bj * 128 + wc * 32 + 8 * fq; const float* xp = Xr + (size_t)row * D + col0;
                        xa[m][bj][0] = *(const f32x4*)xp; xa[m][bj][1] = *(const f32x4*)(xp + 4);
                        if (mode == MODE_GATE) ua[m][bj] = *(const u32x4*)(U + (size_t)row * D + col0); else ua[m][bj] = (u32x4){0u, 0u, 0u, 0u}; }
                __builtin_amdgcn_sched_barrier(0);
#pragma unroll
                for (int m = m0; m < m0 + 2; ++m) { const int row = row0 + ai * 128 + m * 16; float ss = 0.f; const float r = rs[ai][m]; const bool skip = (row & (SEQ - 1)) == 0;
#pragma unroll
                    for (int bj = 0; bj < 2; ++bj) { const int col0 = u.pn * 256 + bj * 128 + wc * 32 + 8 * fq; float* xp = X + (size_t)row * D + col0;
                        f32x4 x0 = xa[m][bj][0], x1 = xa[m][bj][1]; f32x4 v0 = acc[ai][bj][m][0], v1 = acc[ai][bj][m][1];
                        if (mode == MODE_GATE) { const u32x4 uw = ua[m][bj];
                            v0.x = sigmoidf_(v0.x * r) * bf_lo(uw.x); v0.y = sigmoidf_(v0.y * r) * bf_hi(uw.x); v0.z = sigmoidf_(v0.z * r) * bf_lo(uw.y); v0.w = sigmoidf_(v0.w * r) * bf_hi(uw.y);
                            v1.x = sigmoidf_(v1.x * r) * bf_lo(uw.z); v1.y = sigmoidf_(v1.y * r) * bf_hi(uw.z); v1.z = sigmoidf_(v1.z * r) * bf_lo(uw.w); v1.w = sigmoidf_(v1.w * r) * bf_hi(uw.w); }
                        x0 += v0; x1 += v1; ss += dot4(x0) + dot4(x1);
                        if (!skip) { *(f32x4*)xp = x0; *(f32x4*)(xp + 4) = x1; if (!nobf) *(u32x4*)(XBw + (size_t)row * D + col0) = pack8(x0, x1); } }
                    ss += __shfl_xor(ss, 16); ss += __shfl_xor(ss, 32);
                    if (fq == 0 && !skip) sspw[(size_t)row * 16 + u.pn * 4 + wc] = ss; }
            }
            return;
        }
        if (mode == MODE_ATTN_QK) {
            const bool isq = u.pn < 4; const float* g = (isq ? kargs()->a_g_q : kargs()->a_g_k) + (layer >> 1) * 64; const float sc = isq ? 0.125f * LOG2E : 1.f;
            bf16_t* base = (isq ? o0 : o1) + (u.pn & 3) * 256 + wc * 64 + 8 * fq;
            f32x4 gv[2][2];
#pragma unroll
            for (int bj = 0; bj < 2; ++bj)
#pragma unroll
                for (int n = 0; n < 2; ++n) gv[bj][n] = *(const f32x4*)(g + 32 * bj + 8 * fq + 4 * n);
#pragma unroll
            for (int ai = 0; ai < 2; ++ai)
#pragma unroll
                for (int m = 0; m < 4; ++m) { const int row = row0 + ai * 128 + m * 16; const float r = rs[ai][m]; f32x4 v[2][2]; float ss = 0.f;
#pragma unroll
                    for (int bj = 0; bj < 2; ++bj)
#pragma unroll
                        for (int n = 0; n < 2; ++n) { v[bj][n] = acc[ai][bj][m][n] * r; ss += dot4(v[bj][n]); }
                    ss += __shfl_xor(ss, 16); ss += __shfl_xor(ss, 32);
                    const float rn = rsqrtf(ss * (1.f / 64.f) + EPS) * sc;
#pragma unroll
                    for (int bj = 0; bj < 2; ++bj) *(u32x4*)(base + (size_t)row * D + 32 * bj) = pack8(v[bj][0] * rn * gv[bj][0], v[bj][1] * rn * gv[bj][1]); }
            return;
        }
        int act = 0, ld = ld0; float sc = 1.f; bf16_t* base = o0 + u.pn * 256;
        if (mode == MODE_RET_QKG) { if (u.pn < 4) { ld = 1024; } else if (u.pn < 8) { base = o1 + (u.pn - 4) * 256; ld = 1024; sc = 0.0625f; } else { base = o2 + (u.pn - 8) * 256; ld = 2048; act = 1; } }
        else if (mode == MODE_SQRELU) { act = 2; }
        base += wc * 32 + 8 * fq;
#pragma unroll
        for (int ai = 0; ai < 2; ++ai)
#pragma unroll
            for (int m = 0; m < 4; ++m) { const int row = row0 + ai * 128 + m * 16; const float r = rs[ai][m] * sc;
#pragma unroll
                for (int bj = 0; bj < 2; ++bj) { f32x4 v0 = acc[ai][bj][m][0] * r, v1 = acc[ai][bj][m][1] * r;
                    if (act == 1) { v0.x *= sigmoidf_(v0.x); v0.y *= sigmoidf_(v0.y); v0.z *= sigmoidf_(v0.z); v0.w *= sigmoidf_(v0.w); v1.x *= sigmoidf_(v1.x); v1.y *= sigmoidf_(v1.y); v1.z *= sigmoidf_(v1.z); v1.w *= sigmoidf_(v1.w); }
                    else if (act == 2) { v0.x = fmaxf(v0.x, 0.f); v0.y = fmaxf(v0.y, 0.f); v0.z = fmaxf(v0.z, 0.f); v0.w = fmaxf(v0.w, 0.f); v1.x = fmaxf(v1.x, 0.f); v1.y = fmaxf(v1.y, 0.f); v1.z = fmaxf(v1.z, 0.f); v1.w = fmaxf(v1.w, 0.f); v0 = v0 * v0; v1 = v1 * v1; }
                    *(u32x4*)(base + (size_t)row * ld + bj * 128) = pack8(v0, v1); } }
    }
};

__device__ __forceinline__ int rowmap(int nn, int rmode) {
    if (rmode == 1) return nn < 2048 ? ((nn & ~255) + ((nn >> 5) & 1) * 128 + ((nn >> 6) & 3) * 32 + (nn & 31)) : nn;
    if (rmode == 2) return nn < 2048 ? nn : (nn < 4096 ? nn + 2048 : nn - 2048);
    return nn;
}
__device__ __forceinline__ void xpose_item(const float* W, int N, int K, bf16_t* WT, int item, int rmode, const float* gain, int gmask, float gscale, LAS float* scr, int lane) {
    const int nblk = N / 32, kb = item / nblk, nb = item - kb * nblk, k0 = 64 * kb, n0 = 32 * nb;
#pragma unroll 8
    for (int i = 0; i < 32; ++i) { const int kk = 2 * i + (lane >> 5); float v = W[(size_t)(k0 + kk) * N + n0 + (lane & 31)]; if (gain) v *= gain[(k0 + kk) & gmask] * gscale; scr[kk * 33 + (lane & 31)] = v; }
    asm volatile("s_waitcnt lgkmcnt(0)" ::: "memory");
    const int c = lane & 7;
#pragma unroll
    for (int j = 0; j < 4; ++j) { const int n = (lane >> 3) + 8 * j; const LAS float* s = scr + (8 * c) * 33 + n; const int row = rowmap(n0 + n, rmode);
        u32x4 o; o.x = pk2(s[0 * 33], s[1 * 33]); o.y = pk2(s[2 * 33], s[3 * 33]); o.z = pk2(s[4 * 33], s[5 * 33]); o.w = pk2(s[6 * 33], s[7 * 33]);
        *(u32x4*)(WT + (size_t)row * K + k0 + 8 * c) = o; }
    asm volatile("s_waitcnt lgkmcnt(0)" ::: "memory");
}

__device__ __forceinline__ float lambda_init_of(int i) { asm volatile("" : "+s"(i)); return i == 0 ? 0.2f : 0.47071301834f; }

__device__ __forceinline__ void convert_in(int i, LAS unsigned char* lds, int G) {
    KArgs a = kargs();
    const int tid = opaque_tid(), lane = tid & 63, wave = __builtin_amdgcn_readfirstlane(tid >> 6), gw = opaque_bid() * NWAVES + wave, ngw = G * NWAVES;
    LAS float* scr = (LAS float*)(lds + wave * 16384); const int j = i >> 1;
    bf16_t* WT = (bf16_t*)(a->ws + WS_WIN); const float* gain = a->norm_mix + i * D;
    if ((i & 1) == 0) { const float* W = a->a_w_qkv + (size_t)j * D * 3072; for (int it = gw; it < 16 * 96; it += ngw) xpose_item(W, 3072, D, WT, it, 1, gain, 1023, 1.f, scr, lane); }
    else { const float* W = a->r_w_in + (size_t)j * D * 6144; for (int it = gw; it < 16 * 192; it += ngw) xpose_item(W, 6144, D, WT, it, 2, gain, 1023, 1.f, scr, lane); }
}
__device__ __forceinline__ void convert_rest(int i, LAS unsigned char* lds, int G) {
    KArgs a = kargs();
    const int tid = opaque_tid(), lane = tid & 63, wave = __builtin_amdgcn_readfirstlane(tid >> 6), gw = opaque_bid() * NWAVES + wave, ngw = G * NWAVES;
    LAS float* scr = (LAS float*)(lds + wave * 16384); const int j = i >> 1; const bool attn = (i & 1) == 0;
    const int n_out = attn ? 512 : 1024, n_1 = 2048, n_2 = 2048, n_up = 128, n_g = 512, total = n_out + n_1 + n_2 + n_up + n_g;
    for (int it = gw; it < total; it += ngw) {
        int r = it;
        if (r < n_out) { if (attn) xpose_item(a->a_w_o + (size_t)j * D * D, D, D, (bf16_t*)(a->ws + WS_WOUT), r, 0, a->a_g_sub + j * 128, 127, 1.f - lambda_init_of(i), scr, lane);
                         else xpose_item(a->r_w_out + (size_t)j * 2048 * D, D, 2048, (bf16_t*)(a->ws + WS_WOUT), r, 0, a->r_g_gn + j * 512, 511, 1.f, scr, lane); continue; } r -= n_out;
        if (r < n_1) { xpose_item(a->mlp_w1 + (size_t)i * D * FF, FF, D, (bf16_t*)(a->ws + WS_W1), r, 0, a->norm_mlp + i * D, 1023, 1.f, scr, lane); continue; } r -= n_1;
        if (r < n_2) { xpose_item(a->mlp_w2 + (size_t)i * FF * D, D, FF, (bf16_t*)(a->ws + WS_W2), r, 0, nullptr, 0, 1.f, scr, lane); continue; } r -= n_2;
        if (r < n_up) { xpose_item(a->pe_w_up + (size_t)i * PLE * D, D, PLE, (bf16_t*)(a->ws + WS_WUP), r, 0, nullptr, 0, 1.f, scr, lane); continue; } r -= n_up;
        xpose_item(a->pe_w_gate + (size_t)i * D * D, D, D, (bf16_t*)(a->ws + WS_WGATE), r, 0, a->norm_pe + i * D, 1023, 1.f, scr, lane);
    }
    const f32x4* ps = (const f32x4*)(a->p + (size_t)i * M * PLE); u32x4* pd = (u32x4*)(a->ws + WS_PB);
    const int gt = gw * 64 + lane, ngt = ngw * 64;
    for (int q = gt; q < M * PLE / 8; q += ngt) { const f32x4 v0 = ps[2 * q], v1 = ps[2 * q + 1]; pd[q] = pack8(v0, v1); }
}

__device__ __forceinline__ void prologue_rows(int G) {
    KArgs a = kargs();
    const int tid = opaque_tid(), lane = tid & 63, wave = __builtin_amdgcn_readfirstlane(tid >> 6), gw = opaque_bid() * NWAVES + wave, ngw = G * NWAVES;
    float* ssp = (float*)(a->ws + WS_SSP0); bf16_t* XB = (bf16_t*)(a->ws + WS_XB);
    for (int m = gw; m < M; m += ngw) {
        const f32x4* xr = (const f32x4*)(a->x + (size_t)m * D) + lane; u32x2* xb = (u32x2*)(XB + (size_t)m * D) + lane;
        float s = 0.f;
#pragma unroll
        for (int j = 0; j < 4; ++j) { const f32x4 v = xr[64 * j]; s += dot4(v); u32x2 w; w.x = pk2(v.x, v.y); w.y = pk2(v.z, v.w); xb[64 * j] = w; }
#pragma unroll
        for (int o = 1; o < 64; o <<= 1) s += __shfl_xor(s, o);
        if (lane < 16) ssp[(size_t)m * 16 + lane] = (lane == 0) ? s : 0.f;
    }
    if (gw < NBATCH) { const float* xr = a->x + (size_t)gw * SEQ * D; float* xs0 = (float*)(a->ws + WS_SIDE) + SD_XS + gw * D;
        for (int k = lane; k < D; k += 64) xs0[k] = xr[k]; }
}

__device__ __forceinline__ void attn_phase(LAS unsigned char* lds, const bf16_t* Q, const bf16_t* K, const bf16_t* VT, bf16_t* O, float lam, int G) {
    const int tid = opaque_tid(), lane = tid & 63, w = __builtin_amdgcn_readfirstlane(tid >> 6), r = lane & 31, hh = lane >> 5;
    LAS unsigned char* Ks = lds; LAS unsigned char* Vs = lds + 64 * 272; LAS unsigned char* Qs = lds + 36864 + w * 8704 + r * 272 + 16 * hh;
    for (int v = opaque_bid(); v < 256; v += G) {
        const int xcd = v & 7, slot = v >> 3, bh = xcd * 16 + (slot >> 1), par = slot & 1, b = bh >> 3, h = bh & 7;
        const float slope2 = fexp2(-(float)(h + 1)) * LOG2E;
        const size_t tokb = (size_t)b * SEQ;
        for (int ui = 0; ui < 4; ++ui) {
            const int qb = par ? (ui == 0 ? 1 : ui == 1 ? 2 : ui == 2 ? 5 : 6) : (ui == 0 ? 0 : ui == 1 ? 3 : ui == 2 ? 4 : 7);
            const int q0 = qb * 256, q0w = q0 + 32 * w, nt = (q0 + 256) >> 6;
            { const int t2 = opaque_tid(); const bf16_t* qp = Q + (tokb + q0w + (t2 & 31)) * D + h * 128 + 8 * ((t2 >> 5) & 1);
#pragma unroll
              for (int c = 0; c < 2; ++c)
#pragma unroll
                  for (int ks = 0; ks < 4; ++ks) *(LAS bf16x8*)(Qs + (c * 64 + 16 * ks) * 2) = *(const bf16x8*)(qp + c * 64 + 16 * ks); }
            f32x16 o[2][4];
#pragma unroll
            for (int c = 0; c < 2; ++c)
#pragma unroll
                for (int et = 0; et < 4; ++et)
#pragma unroll
                    for (int g = 0; g < 16; ++g) o[c][et][g] = 0.f;
            float mrun[2] = {-1e30f, -1e30f}, lrun[2] = {0.f, 0.f};
            const int kl0 = (tid >> 4) * 272 + (tid & 15) * 16, vl0 = (tid >> 3) * 144 + (tid & 7) * 16;
            const bf16_t* kgb = K + tokb * D + h * 128; const unsigned kof = (unsigned)((tid >> 4) * D + (tid & 15) * 8);
            const bf16_t* vgb = VT + (size_t)(h * 128) * M + tokb; const unsigned vof = (unsigned)((tid >> 3) * M + (tid & 7) * 8);
            for (int t = 0; t < nt; ++t) {
                u32x4 kreg[2], vreg[2];
#pragma unroll
                for (int i = 0; i < 2; ++i) { kreg[i] = *(const u32x4*)(kgb + ((size_t)32 * i * D + (size_t)t * 64 * D) + kof); vreg[i] = *(const u32x4*)(vgb + ((size_t)64 * i * M + t * 64) + vof); }
                __syncthreads();
#pragma unroll
                for (int i = 0; i < 2; ++i) { *(LAS u32x4*)(Ks + kl0 + 32 * i * 272) = kreg[i]; *(LAS u32x4*)(Vs + vl0 + 64 * i * 144) = vreg[i]; }
                __syncthreads();
#pragma unroll
                for (int half = 0; half < 2; ++half) {
                    const int kb = 64 * t + 32 * half;
                    if (kb <= q0w) {
                        const bool diag = (kb == q0w);
                        const float base = slope2 * (float)(kb + 4 * hh);
#pragma unroll
                        for (int c = 0; c < 2; ++c) {
                            f32x16 s;
#pragma unroll
                            for (int g = 0; g < 16; ++g) s[g] = fmaf(slope2, (float)((g & 3) + 8 * (g >> 2)), base);
#pragma unroll
                            for (int ks = 0; ks < 4; ++ks) { const bf16x8 af = *(const LAS bf16x8*)(Ks + (32 * half + r) * 272 + (c * 64 + 16 * ks + 8 * hh) * 2);
                                const bf16x8 bq = *(const LAS bf16x8*)(Qs + (c * 64 + 16 * ks) * 2);
                                s = __builtin_amdgcn_mfma_f32_32x32x16_bf16(af, bq, s, 0, 0, 0); }
                            if (diag) { int rr = r - 4 * hh; asm volatile("" : "+v"(rr));
#pragma unroll
                                for (int g = 0; g < 16; ++g) if ((g & 3) + 8 * (g >> 2) > rr) s[g] = -1e30f; }
                            float mx = s[0];
#pragma unroll
                            for (int g = 1; g < 16; ++g) mx = fmaxf(mx, s[g]);
                            mx = fmaxf(mx, __shfl_xor(mx, 32));
                            const float mnew = fmaxf(mrun[c], mx), alpha = fexp2(mrun[c] - mnew); mrun[c] = mnew;
                            float rsum = 0.f;
#pragma unroll
                            for (int g = 0; g < 16; ++g) { s[g] = fexp2(s[g] - mnew); rsum += s[g]; }
                            lrun[c] = lrun[c] * alpha + rsum;
                            if (__any(alpha != 1.f)) {
#pragma unroll
                                for (int et = 0; et < 4; ++et)
#pragma unroll
                                    for (int g = 0; g < 16; ++g) o[c][et][g] *= alpha; }
                            u32x4 pw0, pw1;
                            pw0.x = pk2(s[0], s[1]); pw0.y = pk2(s[2], s[3]); pw0.z = pk2(s[4], s[5]); pw0.w = pk2(s[6], s[7]);
                            pw1.x = pk2(s[8], s[9]); pw1.y = pk2(s[10], s[11]); pw1.z = pk2(s[12], s[13]); pw1.w = pk2(s[14], s[15]);
                            const bf16x8 pb0 = __builtin_bit_cast(bf16x8, pw0), pb1 = __builtin_bit_cast(bf16x8, pw1);
#pragma unroll
                            for (int et = 0; et < 4; ++et) { const LAS unsigned char* vp = Vs + (32 * et + r) * 144 + (32 * half + 4 * hh) * 2;
                                const s16x4 a0 = *(const LAS s16x4*)(vp), a1 = *(const LAS s16x4*)(vp + 16), a2 = *(const LAS s16x4*)(vp + 32), a3 = *(const LAS s16x4*)(vp + 48);
                                o[c][et] = __builtin_amdgcn_mfma_f32_32x32x16_bf16(__builtin_shufflevector(a0, a1, 0, 1, 2, 3, 4, 5, 6, 7), pb0, o[c][et], 0, 0, 0);
                                o[c][et] = __builtin_amdgcn_mfma_f32_32x32x16_bf16(__builtin_shufflevector(a2, a3, 0, 1, 2, 3, 4, 5, 6, 7), pb1, o[c][et], 0, 0, 0); }
                        }
                    }
                }
            }
            const float l0 = lrun[0] + __shfl_xor(lrun[0], 32), l1 = lrun[1] + __shfl_xor(lrun[1], 32);
            const float i0 = 1.f / l0, i1 = lam / l1; float ss = 0.f;
#pragma unroll
            for (int et = 0; et < 4; ++et)
#pragma unroll
                for (int g = 0; g < 16; ++g) { const float vv = o[0][et][g] * i0 - o[1][et][g] * i1; o[0][et][g] = vv; ss += vv * vv; }
            ss += __shfl_xor(ss, 32);
            const float rn = rsqrtf(ss * (1.f / 128.f) + EPS);
            const int t2 = opaque_tid();
            bf16_t* op = O + (tokb + q0w + (t2 & 31)) * D + h * 128 + 4 * ((t2 >> 5) & 1);
#pragma unroll
            for (int et = 0; et < 4; ++et)
#pragma unroll
                for (int g = 0; g < 4; ++g) { u32x2 wv; wv.x = pk2(o[0][et][4 * g] * rn, o[0][et][4 * g + 1] * rn); wv.y = pk2(o[0][et][4 * g + 2] * rn, o[0][et][4 * g + 3] * rn);
                    *(u32x2*)(op + 32 * et + 8 * g) = wv; }
        }
    }
}


__device__ __forceinline__ void attn_phase2(LAS unsigned char* lds, const bf16_t* Q, const bf16_t* K, const bf16_t* VT, bf16_t* O, float lam, int G) {
    const int tid = opaque_tid(), lane = tid & 63, w = __builtin_amdgcn_readfirstlane(tid >> 6), r = lane & 31, hh = lane >> 5;
    const int qsub = w & 3, c = w >> 2;
    LAS float* EX = (LAS float*)(lds + 71680);
    const int kl0 = (tid >> 4) * 272 + (tid & 15) * 16, vl0 = 17408 + (tid >> 3) * 136 + (tid & 7) * 16;
    for (int v = opaque_bid(); v < 256; v += G) {
      const int xcd = v & 7, slot = v >> 3, grp = slot >> 4, member = slot & 15;
      for (int rd = 0; rd < 8; ++rd) {
        const int bh = xcd * 16 + rd * 2 + grp, b = bh >> 3, h = bh & 7;
        const float slope2 = fexp2(-(float)(h + 1)) * LOG2E;
        const size_t tokb = (size_t)b * SEQ;
        const bf16_t* kg0 = K + (tokb + (tid >> 4)) * D + h * 128 + (tid & 15) * 8;
        const bf16_t* vg0 = VT + (size_t)(h * 128 + (tid >> 3)) * M + tokb + (tid & 7) * 8;
        for (int ui = 0; ui < 1; ++ui) {
            const int qa = (member + (rd >> 1)) & 15, qb = (rd & 1) ? 15 - qa : qa;
            const int q0 = qb * 128, q0w = q0 + 32 * qsub, nt = (q0 + 128) >> 6;
            u32x4 kreg[2], vreg[2];
#pragma unroll
            for (int i = 0; i < 2; ++i) { kreg[i] = *(const u32x4*)(kg0 + (size_t)32 * i * D); vreg[i] = *(const u32x4*)(vg0 + (size_t)64 * i * M); }
            bf16x8 qf[4];
            { const bf16_t* qp = Q + (tokb + q0w + r) * D + h * 128 + c * 64 + 8 * hh;
#pragma unroll
              for (int ks = 0; ks < 4; ++ks) qf[ks] = *(const bf16x8*)(qp + 16 * ks); }
            f32x16 o[4];
#pragma unroll
            for (int et = 0; et < 4; ++et)
#pragma unroll
                for (int g = 0; g < 16; ++g) o[et][g] = 0.f;
            float mrun = -1e30f, lrun = 0.f;
#pragma unroll
            for (int i = 0; i < 2; ++i) { *(LAS u32x4*)(lds + kl0 + 32 * i * 272) = kreg[i]; *(LAS u32x2*)(lds + vl0 + 64 * i * 136) = (u32x2){vreg[i].x, vreg[i].y}; *(LAS u32x2*)(lds + vl0 + 64 * i * 136 + 8) = (u32x2){vreg[i].z, vreg[i].w}; }
            for (int t = 0; t < nt; ++t) {
                __syncthreads();
                if (t + 1 < nt) {
#pragma unroll
                    for (int i = 0; i < 2; ++i) { kreg[i] = *(const u32x4*)(kg0 + (size_t)32 * i * D + (size_t)(t + 1) * 64 * D); vreg[i] = *(const u32x4*)(vg0 + (size_t)64 * i * M + (t + 1) * 64); } }
                const LAS unsigned char* Kt = lds + (t & 1) * 35840; const LAS unsigned char* Vt = Kt + 17408;
                const int kb0 = 64 * t;
                if (kb0 <= q0w) {
                    const bool act1 = (kb0 + 32 <= q0w);
                    const float base0 = slope2 * (float)(kb0 + 4 * hh);
                    f32x16 s0, s1;
#pragma unroll
                    for (int g = 0; g < 16; ++g) { s0[g] = fmaf(slope2, (float)((g & 3) + 8 * (g >> 2)), base0); s1[g] = s0[g] + slope2 * 32.f; }
                    bf16x8 ka[4], kc[4];
#pragma unroll
                    for (int ks = 0; ks < 4; ++ks) ka[ks] = *(const LAS bf16x8*)(Kt + r * 272 + (c * 64 + 16 * ks + 8 * hh) * 2);
                    if (act1) {
#pragma unroll
                        for (int ks = 0; ks < 4; ++ks) kc[ks] = *(const LAS bf16x8*)(Kt + (32 + r) * 272 + (c * 64 + 16 * ks + 8 * hh) * 2); }
                    else {
#pragma unroll
                        for (int ks = 0; ks < 4; ++ks) kc[ks] = ka[ks]; }
                    __builtin_amdgcn_sched_barrier(0);
#pragma unroll
                    for (int ks = 0; ks < 4; ++ks) s0 = __builtin_amdgcn_mfma_f32_32x32x16_bf16(ka[ks], qf[ks], s0, 0, 0, 0);
                    if (act1) {
#pragma unroll
                        for (int ks = 0; ks < 4; ++ks) s1 = __builtin_amdgcn_mfma_f32_32x32x16_bf16(kc[ks], qf[ks], s1, 0, 0, 0); }
                    s16x4 va[4][4];
#pragma unroll
                    for (int et = 0; et < 4; ++et) { const LAS unsigned char* vp = Vt + (32 * et + r) * 136 + (4 * hh) * 2;
                        va[et][0] = *(const LAS s16x4*)(vp); va[et][1] = *(const LAS s16x4*)(vp + 16); va[et][2] = *(const LAS s16x4*)(vp + 32); va[et][3] = *(const LAS s16x4*)(vp + 48); }
                    __builtin_amdgcn_sched_barrier(0);
                    { int rr = r - 4 * hh; asm volatile("" : "+v"(rr));
                      if (kb0 == q0w) {
#pragma unroll
                          for (int g = 0; g < 16; ++g) if ((g & 3) + 8 * (g >> 2) > rr) s0[g] = -1e30f; }
                      if (kb0 + 32 == q0w) {
#pragma unroll
                          for (int g = 0; g < 16; ++g) if ((g & 3) + 8 * (g >> 2) > rr) s1[g] = -1e30f; } }
                    float mx = s0[0];
#pragma unroll
                    for (int g = 1; g < 16; ++g) mx = fmaxf(mx, s0[g]);
                    if (act1) {
#pragma unroll
                        for (int g = 0; g < 16; ++g) mx = fmaxf(mx, s1[g]); }
                    mx = fmaxf(mx, __shfl_xor(mx, 32));
                    if (__any(mx > mrun + 12.f)) { const float mnew = fmaxf(mrun, mx), alpha = fexp2(mrun - mnew); mrun = mnew; lrun *= alpha;
#pragma unroll
                        for (int et = 0; et < 4; ++et)
#pragma unroll
                            for (int g = 0; g < 16; ++g) o[et][g] *= alpha; }
                    float rsum = 0.f;
#pragma unroll
                    for (int g = 0; g < 16; ++g) { s0[g] = fexp2(s0[g] - mrun); rsum += s0[g]; }
                    { u32x4 pw0, pw1;
                      pw0.x = pk2(s0[0], s0[1]); pw0.y = pk2(s0[2], s0[3]); pw0.z = pk2(s0[4], s0[5]); pw0.w = pk2(s0[6], s0[7]);
                      pw1.x = pk2(s0[8], s0[9]); pw1.y = pk2(s0[10], s0[11]); pw1.z = pk2(s0[12], s0[13]); pw1.w = pk2(s0[14], s0[15]);
                      const bf16x8 pb0 = __builtin_bit_cast(bf16x8, pw0), pb1 = __builtin_bit_cast(bf16x8, pw1);
                      __builtin_amdgcn_sched_barrier(0);
#pragma unroll
                      for (int et = 0; et < 4; ++et) {
                          o[et] = __builtin_amdgcn_mfma_f32_32x32x16_bf16(__builtin_shufflevector(va[et][0], va[et][1], 0, 1, 2, 3, 4, 5, 6, 7), pb0, o[et], 0, 0, 0);
                          o[et] = __builtin_amdgcn_mfma_f32_32x32x16_bf16(__builtin_shufflevector(va[et][2], va[et][3], 0, 1, 2, 3, 4, 5, 6, 7), pb1, o[et], 0, 0, 0); } }
                    if (act1) {
#pragma unroll
                        for (int et = 0; et < 4; ++et) { const LAS unsigned char* vp = Vt + (32 * et + r) * 136 + (32 + 4 * hh) * 2;
                            va[et][0] = *(const LAS s16x4*)(vp); va[et][1] = *(const LAS s16x4*)(vp + 16); va[et][2] = *(const LAS s16x4*)(vp + 32); va[et][3] = *(const LAS s16x4*)(vp + 48); }
                        __builtin_amdgcn_sched_barrier(0);
#pragma unroll
                        for (int g = 0; g < 16; ++g) { s1[g] = fexp2(s1[g] - mrun); rsum += s1[g]; }
                        u32x4 pw0, pw1;
                        pw0.x = pk2(s1[0], s1[1]); pw0.y = pk2(s1[2], s1[3]); pw0.z = pk2(s1[4], s1[5]); pw0.w = pk2(s1[6], s1[7]);
                        pw1.x = pk2(s1[8], s1[9]); pw1.y = pk2(s1[10], s1[11]); pw1.z = pk2(s1[12], s1[13]); pw1.w = pk2(s1[14], s1[15]);
                        const bf16x8 pb0 = __builtin_bit_cast(bf16x8, pw0), pb1 = __builtin_bit_cast(bf16x8, pw1);
                        __builtin_amdgcn_sched_barrier(0);
#pragma unroll
                        for (int et = 0; et < 4; ++et) {
                            o[et] = __builtin_amdgcn_mfma_f32_32x32x16_bf16(__builtin_shufflevector(va[et][0], va[et][1], 0, 1, 2, 3, 4, 5, 6, 7), pb0, o[et], 0, 0, 0);
                            o[et] = __builtin_amdgcn_mfma_f32_32x32x16_bf16(__builtin_shufflevector(va[et][2], va[et][3], 0, 1, 2, 3, 4, 5, 6, 7), pb1, o[et], 0, 0, 0); } }
                    lrun += rsum;
                }
                if (t + 1 < nt) { LAS unsigned char* nb = lds + ((t + 1) & 1) * 35840;
#pragma unroll
                    for (int i = 0; i < 2; ++i) { *(LAS u32x4*)(nb + kl0 + 32 * i * 272) = kreg[i]; *(LAS u32x2*)(nb + vl0 + 64 * i * 136) = (u32x2){vreg[i].x, vreg[i].y}; *(LAS u32x2*)(nb + vl0 + 64 * i * 136 + 8) = (u32x2){vreg[i].z, vreg[i].w}; } }
            }
            const float l = lrun + __shfl_xor(lrun, 32);
            if (c == 1) { const float sc = lam / l;
#pragma unroll
                for (int et = 0; et < 4; ++et)
#pragma unroll
                    for (int g = 0; g < 16; ++g) EX[(qsub * 64 + et * 16 + g) * 64 + lane] = o[et][g] * sc; }
            __syncthreads();
            if (c == 0) { const float inv = 1.f / l; float ss = 0.f;
#pragma unroll
                for (int et = 0; et < 4; ++et)
#pragma unroll
                    for (int g = 0; g < 16; ++g) { const float vv = o[et][g] * inv - EX[(qsub * 64 + et * 16 + g) * 64 + lane]; o[et][g] = vv; ss += vv * vv; }
                ss += __shfl_xor(ss, 32);
                const float rn = rsqrtf(ss * (1.f / 128.f) + EPS);
                bf16_t* op = O + (tokb + q0w + r) * D + h * 128 + 4 * hh;
#pragma unroll
                for (int et = 0; et < 4; ++et)
#pragma unroll
                    for (int g = 0; g < 4; ++g) { u32x2 wv; wv.x = pk2(o[et][4 * g] * rn, o[et][4 * g + 1] * rn); wv.y = pk2(o[et][4 * g + 2] * rn, o[et][4 * g + 3] * rn);
                        *(u32x2*)(op + 32 * et + 8 * g) = wv; } }
        }
      }
    }
}

__device__ __forceinline__ void ret_phase(LAS unsigned char* lds, const bf16_t* Q, const bf16_t* K, const bf16_t* VT, bf16_t* TG, float* SSO, int G) {
    const int tid = opaque_tid(), lane = tid & 63, w = __builtin_amdgcn_readfirstlane(tid >> 6), r = lane & 31, hh = lane >> 5;
    const int ib = w & 3, eb = w >> 2, db = w;
    LAS unsigned char* Kn = lds; LAS unsigned char* Vn = lds + 128 * 528; LAS unsigned char* RT = lds + 128 * 528 + 64 * 272;
    for (int v = opaque_bid(); v < 256; v += G) {
        const int xcd = v & 7, slot = v >> 3;
        for (int k2 = 0; k2 < 2; ++k2) {
            const int jj = slot + 32 * k2, bh = xcd * 8 + (jj >> 3), vs = jj & 7, b = bh >> 2, h = bh & 3;
            const float l2g = log2f(1.f - fexp2(-5.f - (float)h)), cdec = fexp2(128.f * l2g);
            const size_t tokb = (size_t)b * SEQ;
            f32x16 racc[2];
#pragma unroll
            for (int e2 = 0; e2 < 2; ++e2)
#pragma unroll
                for (int g = 0; g < 16; ++g) racc[e2][g] = 0.f;
            __syncthreads();
            const int kl0 = (tid >> 5) * 528 + (tid & 31) * 16, vl0 = (tid >> 4) * 272 + (tid & 15) * 16;
            const bf16_t* kg0 = K + (tokb + (tid >> 5)) * D + h * 256 + (tid & 31) * 8;
            const bf16_t* vg0 = VT + (size_t)(h * 512 + vs * 64 + (tid >> 4)) * M + tokb + (tid & 15) * 8;
            u32x4 kreg[8], vreg[2];
#pragma unroll
            for (int i = 0; i < 8; ++i) kreg[i] = *(const u32x4*)(kg0 + (size_t)16 * i * D);
#pragma unroll
            for (int i = 0; i < 2; ++i) vreg[i] = *(const u32x4*)(vg0 + (size_t)32 * i * M);
            for (int n = 0; n < 16; ++n) {
                const size_t tok0 = tokb + 128 * n;
#pragma unroll
                for (int i = 0; i < 8; ++i) *(LAS u32x4*)(Kn + kl0 + 16 * i * 528) = kreg[i];
#pragma unroll
                for (int i = 0; i < 2; ++i) *(LAS u32x4*)(Vn + vl0 + 32 * i * 272) = vreg[i];
                __syncthreads();
                if (n + 1 < 16) {
#pragma unroll
                    for (int i = 0; i < 8; ++i) kreg[i] = *(const u32x4*)(kg0 + (size_t)16 * i * D + (size_t)(n + 1) * 128 * D);
#pragma unroll
                    for (int i = 0; i < 2; ++i) vreg[i] = *(const u32x4*)(vg0 + (size_t)32 * i * M + (n + 1) * 128); }
                bf16x8 qf[16];
                { const bf16_t* qp = Q + (tok0 + 32 * ib + r) * D + h * 256 + 8 * hh;
#pragma unroll
                  for (int s = 0; s < 16; ++s) qf[s] = *(const bf16x8*)(qp + 16 * s); }
                f32x16 acc;
#pragma unroll
                for (int g = 0; g < 16; ++g) acc[g] = 0.f;
                if (n > 0) {
#pragma unroll
                    for (int s = 0; s < 16; ++s) { const bf16x8 af = *(const LAS bf16x8*)(RT + (32 * eb + r) * 528 + (16 * s + 8 * hh) * 2); acc = __builtin_amdgcn_mfma_f32_32x32x16_bf16(af, qf[s], acc, 0, 0, 0); }
#pragma unroll
                    for (int g = 0; g < 16; ++g) acc[g] *= cdec; }
                for (int jb = 0; jb <= ib; ++jb) {
                    f32x16 st;
#pragma unroll
                    for (int g = 0; g < 16; ++g) st[g] = 0.f;
#pragma unroll
                    for (int s = 0; s < 16; ++s) { const bf16x8 af = *(const LAS bf16x8*)(Kn + (32 * jb + r) * 528 + (16 * s + 8 * hh) * 2); st = __builtin_amdgcn_mfma_f32_32x32x16_bf16(af, qf[s], st, 0, 0, 0); }
                    if (jb == ib) { int rr = r - 4 * hh; asm volatile("" : "+v"(rr));
#pragma unroll
                        for (int g = 0; g < 16; ++g) if ((g & 3) + 8 * (g >> 2) > rr) st[g] = 0.f; }
                    u32x4 pw0, pw1;
                    pw0.x = pk2(st[0], st[1]); pw0.y = pk2(st[2], st[3]); pw0.z = pk2(st[4], st[5]); pw0.w = pk2(st[6], st[7]);
                    pw1.x = pk2(st[8], st[9]); pw1.y = pk2(st[10], st[11]); pw1.z = pk2(st[12], st[13]); pw1.w = pk2(st[14], st[15]);
                    const LAS unsigned char* vp = Vn + (32 * eb + r) * 272 + (32 * jb + 4 * hh) * 2;
                    const s16x4 a0 = *(const LAS s16x4*)(vp), a1 = *(const LAS s16x4*)(vp + 16), a2 = *(const LAS s16x4*)(vp + 32), a3 = *(const LAS s16x4*)(vp + 48);
                    acc = __builtin_amdgcn_mfma_f32_32x32x16_bf16(__builtin_shufflevector(a0, a1, 0, 1, 2, 3, 4, 5, 6, 7), __builtin_bit_cast(bf16x8, pw0), acc, 0, 0, 0);
                    acc = __builtin_amdgcn_mfma_f32_32x32x16_bf16(__builtin_shufflevector(a2, a3, 0, 1, 2, 3, 4, 5, 6, 7), __builtin_bit_cast(bf16x8, pw1), acc, 0, 0, 0);
                }
                { const int i = 32 * ib + r; const float fac = fexp2(l2g * (float)(i - 127)); float ss = 0.f;
#pragma unroll
                  for (int g = 0; g < 16; ++g) { acc[g] *= fac; ss += acc[g] * acc[g]; }
                  ss += __shfl_xor(ss, 32);
                  const size_t tok = tok0 + i;
                  if (hh == 0) SSO[tok * 64 + h * 16 + vs * 2 + eb] = ss;
                  bf16_t* gp = TG + tok * 2048 + h * 512 + vs * 64 + 32 * eb + 4 * hh;
#pragma unroll
                  for (int g = 0; g < 4; ++g) { const u32x2 gw = *(const u32x2*)(gp + 8 * g); u32x2 ov;
                      ov.x = pk2(acc[4 * g] * bf_lo(gw.x), acc[4 * g + 1] * bf_hi(gw.x)); ov.y = pk2(acc[4 * g + 2] * bf_lo(gw.y), acc[4 * g + 3] * bf_hi(gw.y)); *(u32x2*)(gp + 8 * g) = ov; } }
#pragma unroll
                for (int e2 = 0; e2 < 2; ++e2)
#pragma unroll
                    for (int g = 0; g < 16; ++g) racc[e2][g] *= cdec;
#pragma unroll
                for (int s = 0; s < 8; ++s) { const LAS unsigned short* kp = (const LAS unsigned short*)Kn + (16 * s + 8 * hh) * 264 + 32 * db + r;
                    u32x4 aw;
                    aw.x = (unsigned)kp[0] | ((unsigned)kp[264] << 16); aw.y = (unsigned)kp[2 * 264] | ((unsigned)kp[3 * 264] << 16);
                    aw.z = (unsigned)kp[4 * 264] | ((unsigned)kp[5 * 264] << 16); aw.w = (unsigned)kp[6 * 264] | ((unsigned)kp[7 * 264] << 16);
                    const bf16x8 af = __builtin_bit_cast(bf16x8, aw);
#pragma unroll
                    for (int e2 = 0; e2 < 2; ++e2) { const bf16x8 bb = *(const LAS bf16x8*)(Vn + (32 * e2 + r) * 272 + (16 * s + 8 * hh) * 2); racc[e2] = __builtin_amdgcn_mfma_f32_32x32x16_bf16(af, bb, racc[e2], 0, 0, 0); } }
                __syncthreads();
#pragma unroll
                for (int e2 = 0; e2 < 2; ++e2)
#pragma unroll
                    for (int g = 0; g < 4; ++g) { u32x2 wv; wv.x = pk2(racc[e2][4 * g], racc[e2][4 * g + 1]); wv.y = pk2(racc[e2][4 * g + 2], racc[e2][4 * g + 3]);
                        *(LAS u32x2*)(RT + (32 * e2 + r) * 528 + (32 * db + 8 * g + 4 * hh) * 2) = wv; }
            }
        }
    }
}


__device__ __forceinline__ float bf2f(bf16_t v) { return __uint_as_float((unsigned)v << 16); }
__device__ __forceinline__ void attn_naive(const bf16_t* Q, const bf16_t* K, const bf16_t* VT, bf16_t* O, float lam, int G) {
    const int tid = opaque_tid(), lane = tid & 63, wave = __builtin_amdgcn_readfirstlane(tid >> 6), gw = opaque_bid() * NWAVES + wave, ngw = G * NWAVES;
    for (int row = gw; row < NBATCH * 8 * SEQ; row += ngw) {
        const int q = row % SEQ, bh = row / SEQ, h = bh & 7, b = bh >> 3; const size_t tokb = (size_t)b * SEQ;
        const float slope2 = fexp2(-(float)(h + 1)) * LOG2E;
        float oc[2][2]; float res0 = 0.f, res1 = 0.f;
        for (int c = 0; c < 2; ++c) {
            const bf16_t* qp = Q + (tokb + q) * D + h * 128 + c * 64;
            float m = -1e30f, l = 0.f;
            for (int k0 = 0; k0 <= q; k0 += 64) { const int k = k0 + lane; float sc = -1e30f;
                if (k <= q) { const bf16_t* kp = K + (tokb + k) * D + h * 128 + c * 64; float d = 0.f; for (int t = 0; t < 64; ++t) d = fmaf(bf2f(qp[t]), bf2f(kp[t]), d); sc = d + slope2 * (float)k; }
                const float mn = fmaxf(m, sc); l = l * fexp2(m - mn) + ((k <= q) ? fexp2(sc - mn) : 0.f); m = mn; }
            float mg = m;
#pragma unroll
            for (int o = 1; o < 64; o <<= 1) mg = fmaxf(mg, __shfl_xor(mg, o));
            l = l * fexp2(m - mg);
#pragma unroll
            for (int o = 1; o < 64; o <<= 1) l += __shfl_xor(l, o);
            float o0 = 0.f, o1 = 0.f;
            for (int k0 = 0; k0 <= q; k0 += 64) { const int k = k0 + lane; float pv = 0.f;
                if (k <= q) { const bf16_t* kp = K + (tokb + k) * D + h * 128 + c * 64; float d = 0.f; for (int t = 0; t < 64; ++t) d = fmaf(bf2f(qp[t]), bf2f(kp[t]), d); pv = fexp2(d + slope2 * (float)k - mg); }
                const int nk = (q - k0 + 1) < 64 ? (q - k0 + 1) : 64;
                for (int jj = 0; jj < nk; ++jj) { const float pj = __shfl(pv, jj); const size_t tk = tokb + k0 + jj;
                    o0 = fmaf(pj, bf2f(VT[(size_t)(h * 128 + lane) * M + tk]), o0); o1 = fmaf(pj, bf2f(VT[(size_t)(h * 128 + 64 + lane) * M + tk]), o1); } }
            oc[c][0] = o0 / l; oc[c][1] = o1 / l;
        }
        res0 = oc[0][0] - lam * oc[1][0]; res1 = oc[0][1] - lam * oc[1][1];
        float ss = res0 * res0 + res1 * res1;
#pragma unroll
        for (int o = 1; o < 64; o <<= 1) ss += __shfl_xor(ss, o);
        const float rn = rsqrtf(ss * (1.f / 128.f) + EPS);
        bf16_t* op = O + (tokb + q) * D + h * 128;
        op[lane] = (bf16_t)(pk2(res0 * rn, 0.f) & 0xffffu); op[64 + lane] = (bf16_t)(pk2(res1 * rn, 0.f) & 0xffffu);
    }
}
__device__ __forceinline__ void ret_naive(const bf16_t* Q, const bf16_t* K, const bf16_t* VT, bf16_t* TG, float* SSO, int G) {
    const int tid = opaque_tid(), lane = tid & 63, wave = __builtin_amdgcn_readfirstlane(tid >> 6), gw = opaque_bid() * NWAVES + wave, ngw = G * NWAVES;
    for (int row = gw; row < NBATCH * 4 * SEQ; row += ngw) {
        const int i = row % SEQ, bh = row / SEQ, h = bh & 3, b = bh >> 2; const size_t tokb = (size_t)b * SEQ;
        const float l2g = log2f(1.f - fexp2(-5.f - (float)h));
        const bf16_t* qp = Q + (tokb + i) * D + h * 256;
        float o[8];
#pragma unroll
        for (int t = 0; t < 8; ++t) o[t] = 0.f;
        for (int j0 = 0; j0 <= i; j0 += 64) { const int j = j0 + lane; float wv = 0.f;
            if (j <= i) { const bf16_t* kp = K + (tokb + j) * D + h * 256; float d = 0.f; for (int t = 0; t < 256; ++t) d = fmaf(bf2f(qp[t]), bf2f(kp[t]), d);
                wv = d * fexp2(l2g * (float)((i - j) - (127 - (j & 127)))); }
            const int nj = (i - j0 + 1) < 64 ? (i - j0 + 1) : 64;
            for (int jj = 0; jj < nj; ++jj) { const float wj = __shfl(wv, jj); const size_t tk = tokb + j0 + jj;
#pragma unroll
                for (int t = 0; t < 8; ++t) o[t] = fmaf(wj, bf2f(VT[(size_t)(h * 512 + 64 * t + lane) * M + tk]), o[t]); } }
        float ss = 0.f;
#pragma unroll
        for (int t = 0; t < 8; ++t) ss += o[t] * o[t];
#pragma unroll
        for (int of = 1; of < 64; of <<= 1) ss += __shfl_xor(ss, of);
        const size_t tok = tokb + i;
        if (lane < 16) SSO[tok * 64 + h * 16 + lane] = (lane == 0) ? ss : 0.f;
        bf16_t* gp = TG + tok * 2048 + h * 512;
#pragma unroll
        for (int t = 0; t < 8; ++t) gp[64 * t + lane] = (bf16_t)(pk2(o[t] * bf2f(gp[64 * t + lane]), 0.f) & 0xffffu);
    }
}

__device__ __forceinline__ void ret_norm_phase(bf16_t* TG, const float* SSO, int G) {
    const int tid = opaque_tid(), lane = tid & 63, wave = __builtin_amdgcn_readfirstlane(tid >> 6), gw = opaque_bid() * NWAVES + wave, ngw = G * NWAVES;
    for (int idx0 = gw * 4; idx0 < M * 4; idx0 += ngw * 4) {
        float sp[4]; u32x4 v[4];
#pragma unroll
        for (int u = 0; u < 4; ++u) { sp[u] = (lane < 16) ? SSO[(size_t)(idx0 + u) * 16 + lane] : 0.f; v[u] = *((const u32x4*)(TG + (size_t)(idx0 + u) * 512) + lane); }
#pragma unroll
        for (int u = 0; u < 4; ++u) { float s = sp[u];
#pragma unroll
            for (int o = 1; o < 16; o <<= 1) s += __shfl_xor(s, o);
            s = __shfl(s, 0);
            const float rn = rsqrtf(s * (1.f / 512.f) + EPS); u32x4 o;
            o.x = pk2(bf_lo(v[u].x) * rn, bf_hi(v[u].x) * rn); o.y = pk2(bf_lo(v[u].y) * rn, bf_hi(v[u].y) * rn); o.z = pk2(bf_lo(v[u].z) * rn, bf_hi(v[u].z) * rn); o.w = pk2(bf_lo(v[u].w) * rn, bf_hi(v[u].w) * rn);
            *((u32x4*)(TG + (size_t)(idx0 + u) * 512) + lane) = o; }
    }
}

enum { SK_PROJ = 0, SK_OUT = 1, SK_W1 = 2, SK_UP = 3, SK_W2 = 4, SK_GATE = 5 };
__device__ __forceinline__ void side_step(int kind, int i, int sv, LAS unsigned char* lds, int G, int boff = 0) {
    KArgs a = kargs(); const int tid = opaque_tid(), lane = tid & 63, wave = __builtin_amdgcn_readfirstlane(tid >> 6), bid = opaque_bid();
    float* SD = (float*)(a->ws + WS_SIDE);
    float* XSA = SD + SD_XS; float* XSB = SD + SD_XS + 16384; float* PQ = SD + SD_PRJ;
    const bool attn = (i & 1) == 0; const int j = i >> 1;
    const float* xin = XSA; int xs = 1024, K = 1024, ldw = 1024, nitems = 16; const float* gain = nullptr; const float* W = nullptr;
    if (kind == SK_PROJ) { gain = a->norm_mix + i * D; if (attn) { W = a->a_w_qkv + (size_t)j * D * 3072 + 2048; ldw = 3072; } else { W = a->r_w_in + (size_t)j * D * 6144; ldw = 6144; nitems = 96; } }
    else if (kind == SK_OUT) { xin = SD + SD_AV; xs = 2048; if (attn) { W = a->a_w_o + (size_t)j * D * D; } else { K = 2048; W = a->r_w_out + (size_t)j * 2048 * D; } }
    else if (kind == SK_W1) { xin = XSB; gain = a->norm_mlp + i * D; W = a->mlp_w1 + (size_t)i * D * FF; ldw = FF; nitems = 64; }
    else if (kind == SK_UP) { xin = a->p + (size_t)i * M * PLE; xs = SEQ * PLE; K = PLE; W = a->pe_w_up + (size_t)i * PLE * D; }
    else if (kind == SK_W2) { xin = SD + SD_HS; xs = FF; W = a->mlp_w2 + (size_t)i * FF * D; nitems = 64; }
    else { xin = XSB; gain = a->norm_pe + i * D; W = a->pe_w_gate + (size_t)i * D * D; }
    LAS float* part = (LAS float*)lds;
    LAS float* ssqp = (LAS float*)(lds + 32768);
    LAS float* xst = (LAS float*)(lds + 36864 + wave * 8192);
    for (int it = bid - boff; it < nitems; it += G) {
        if (it < 0) continue;
        const int cg_ = (kind == SK_W2) ? (it & 15) : it, kq = (kind == SK_W2) ? (it >> 4) : 0;
        const int n0 = cg_ * 64, kper = K >> 3, kb0 = kq * 1024 + wave * kper;
        float acc[16];
#pragma unroll
        for (int b = 0; b < 16; ++b) acc[b] = 0.f;
        for (int ks0 = 0; ks0 < kper; ks0 += 128) {
            const int ksn = (kper - ks0) < 128 ? (kper - ks0) : 128, kbase = kb0 + ks0;
            const int nq = ksn >> 2;
            float w[32];
#pragma unroll
            for (int t = 0; t < 32; ++t) w[t] = W[(size_t)(kbase + t) * ldw + n0 + lane];
            for (int q = lane; q < 16 * nq; q += 64) { const int b = q / nq, c4 = (q - b * nq) * 4, k = kbase + c4;
                f32x4 xv = *(const f32x4*)(xin + (size_t)b * xs + k);
                if (kind == SK_GATE) {
#pragma unroll
                    for (int qq = 0; qq < 4; ++qq) xv += *(const f32x4*)(PQ + qq * 16384 + b * D + k); }
                if (gain) { float sr = dot4(xv);
#pragma unroll
                    for (int o = 1; o < 32; o <<= 1) sr += __shfl_xor(sr, o);
                    if ((lane & 31) == 0) ssqp[wave * 16 + b] = sr;
                    xv = xv * *(const f32x4*)(gain + k); }
                xst[(c4 + 0) * 16 + b] = xv.x; xst[(c4 + 1) * 16 + b] = xv.y; xst[(c4 + 2) * 16 + b] = xv.z; xst[(c4 + 3) * 16 + b] = xv.w;
            }
            asm volatile("s_waitcnt lgkmcnt(0)" ::: "memory");
            for (int kb = 0; kb < ksn; kb += 32) {
                float wn[32]; const bool more = (kb + 32 < ksn);
                if (more) {
#pragma unroll
                    for (int t = 0; t < 32; ++t) wn[t] = W[(size_t)(kbase + kb + 32 + t) * ldw + n0 + lane]; }
                else {
#pragma unroll
                    for (int t = 0; t < 32; ++t) wn[t] = 0.f; }
                __builtin_amdgcn_sched_barrier(0);
#pragma unroll
                for (int t = 0; t < 32; ++t) { const LAS f32x4* xp = (const LAS f32x4*)(xst + (kb + t) * 16);
                    const f32x4 x0 = xp[0], x1 = xp[1], x2 = xp[2], x3 = xp[3];
                    acc[0] = fmaf(x0.x, w[t], acc[0]); acc[1] = fmaf(x0.y, w[t], acc[1]); acc[2] = fmaf(x0.z, w[t], acc[2]); acc[3] = fmaf(x0.w, w[t], acc[3]);
                    acc[4] = fmaf(x1.x, w[t], acc[4]); acc[5] = fmaf(x1.y, w[t], acc[5]); acc[6] = fmaf(x1.z, w[t], acc[6]); acc[7] = fmaf(x1.w, w[t], acc[7]);
                    acc[8] = fmaf(x2.x, w[t], acc[8]); acc[9] = fmaf(x2.y, w[t], acc[9]); acc[10] = fmaf(x2.z, w[t], acc[10]); acc[11] = fmaf(x2.w, w[t], acc[11]);
                    acc[12] = fmaf(x3.x, w[t], acc[12]); acc[13] = fmaf(x3.y, w[t], acc[13]); acc[14] = fmaf(x3.z, w[t], acc[14]); acc[15] = fmaf(x3.w, w[t], acc[15]); }
#pragma unroll
                for (int t = 0; t < 32; ++t) w[t] = wn[t];
            }
            asm volatile("s_waitcnt lgkmcnt(0)" ::: "memory");
        }
#pragma unroll
        for (int b = 0; b < 16; ++b) part[(wave * 16 + b) * 64 + lane] = acc[b];
        __syncthreads();
#pragma unroll
        for (int rr = 0; rr < 2; ++rr) { const int b = 2 * wave + rr; float v = 0.f;
#pragma unroll
            for (int w2 = 0; w2 < 8; ++w2) v += part[(w2 * 16 + b) * 64 + lane];
            if (gain) { float sq = 0.f;
#pragma unroll
                for (int w2 = 0; w2 < 8; ++w2) sq += ssqp[w2 * 16 + b];
                v *= rsqrtf(sq * (1.f / D) + EPS); }
            const int n = n0 + lane;
            if (kind == SK_PROJ) SD[SD_PRJ + b * 6144 + n] = v;
            else if (kind == SK_W1) { const float r = fmaxf(v, 0.f); SD[SD_HS + b * FF + n] = r * r; }
            else if (kind == SK_UP) SD[SD_US + b * D + n] = v;
            else if (kind == SK_OUT) XSB[b * D + n] = XSA[b * D + n] + v;
            else if (kind == SK_W2) PQ[kq * 16384 + b * D + n] = v;
            else { float xm = XSB[b * D + n];
#pragma unroll
                for (int qq = 0; qq < 4; ++qq) xm += PQ[qq * 16384 + b * D + n];
                const float xn = fmaf(sigmoidf_(v), SD[SD_US + b * D + n], xm);
                XSA[b * D + n] = xn; const size_t row = (size_t)b * SEQ; a->out[row * D + n] = xn;
                ((bf16_t*)(a->ws + WS_XB))[row * D + n] = (bf16_t)(pk2(xn, 0.f) & 0xffffu);
                float ss = xn * xn;
#pragma unroll
                for (int o = 1; o < 64; o <<= 1) ss += __shfl_xor(ss, o);
                if (lane == 0) ((float*)(a->ws + (sv ? WS_SSP0 : WS_SSP1)))[row * 16 + it] = ss; }
        }
        __syncthreads();
    }
}
__device__ __forceinline__ void side_mixer(int i, float lam, int G) {
    KArgs a = kargs(); const int tid = opaque_tid(), lane = tid & 63, wave = __builtin_amdgcn_readfirstlane(tid >> 6), gw = opaque_bid() * NWAVES + wave;
    float* SD = (float*)(a->ws + WS_SIDE); const int j = i >> 1;
    if ((i & 1) == 0) { if (gw < NBATCH * 8) { const int b = gw >> 3, h = gw & 7; const float* vp = SD + SD_PRJ + b * 6144 + h * 128;
            const float o0 = (1.f - lam) * vp[lane], o1 = (1.f - lam) * vp[64 + lane]; float ss = o0 * o0 + o1 * o1;
#pragma unroll
            for (int o = 1; o < 64; o <<= 1) ss += __shfl_xor(ss, o);
            const float rn = rsqrtf(ss * (1.f / 128.f) + EPS) * (1.f - lambda_init_of(i)); const float* g = a->a_g_sub + j * 128;
            SD[SD_AV + b * 2048 + h * 128 + lane] = o0 * rn * g[lane]; SD[SD_AV + b * 2048 + h * 128 + 64 + lane] = o1 * rn * g[64 + lane]; } }
    else { if (gw < NBATCH * 4) { const int b = gw >> 2, h = gw & 3; const float* pp = SD + SD_PRJ + b * 6144; float w = 0.f;
#pragma unroll
            for (int t = 0; t < 4; ++t) w = fmaf(pp[h * 256 + 64 * t + lane], pp[1024 + h * 256 + 64 * t + lane], w);
#pragma unroll
            for (int o = 1; o < 64; o <<= 1) w += __shfl_xor(w, o);
            w *= 0.0625f; float ov[8]; float ss = 0.f;
#pragma unroll
            for (int t = 0; t < 8; ++t) { ov[t] = w * pp[2048 + h * 512 + 64 * t + lane]; ss = fmaf(ov[t], ov[t], ss); }
#pragma unroll
            for (int o = 1; o < 64; o <<= 1) ss += __shfl_xor(ss, o);
            const float rn = rsqrtf(ss * (1.f / 512.f) + EPS); const float* g = a->r_g_gn + j * 512;
#pragma unroll
            for (int t = 0; t < 8; ++t) { const float gt = pp[4096 + h * 512 + 64 * t + lane]; SD[SD_AV + b * 2048 + h * 512 + 64 * t + lane] = gt * sigmoidf_(gt) * ov[t] * rn * g[64 * t + lane]; } } }
}

#define XB_TMO      128
#define XB_XCNT(j)  (256  + 64 * (j))
#define XB_XSUB(j)  (1280 + 64 * (j))
#define XB_XGEN(j)  (2304 + 64 * (j))
#define XB_TOP      3328
#define XB_TOPGEN   3392
#define XCD_BAR_WORDS 3456
#define XB_SPIN_CAP (1u << 18)

__device__ __forceinline__ unsigned xb_ld(unsigned* p)              { return __hip_atomic_load(p, __ATOMIC_RELAXED, __HIP_MEMORY_SCOPE_AGENT); }
__device__ __forceinline__ unsigned xb_add(unsigned* p, unsigned v) { return __hip_atomic_fetch_add(p, v, __ATOMIC_RELAXED, __HIP_MEMORY_SCOPE_AGENT); }
__device__ __forceinline__ unsigned xb_xcc_id() { return (unsigned)__builtin_amdgcn_s_getreg((3 << 11) | 20) & 0xFu; }
#define XB_SPIN(cond, bar) do { unsigned _sp = 0; while (cond) { __builtin_amdgcn_s_sleep(1); \
    if ((++_sp & 255u) == 0u) { if (xb_ld(&(bar)[XB_TMO])) break; if (_sp > XB_SPIN_CAP) { atomicAdd(&(bar)[XB_TMO], 1u); break; } } } } while (0)

struct XcdBarrier {
    unsigned* bar; unsigned x;
    volatile LAS unsigned* st;
};

__device__ __forceinline__ XcdBarrier xcd_barrier_post(unsigned* bar, volatile LAS unsigned* st) {
    XcdBarrier b; b.bar = bar; b.x = xb_xcc_id(); b.st = st;
    if (threadIdx.x == 0) (void)xb_add(&bar[XB_XCNT(b.x)], 1u);
    return b;
}
__device__ __forceinline__ void xcd_barrier_complete(unsigned* bar, unsigned x, unsigned& nloc, unsigned& nx) {
    const unsigned G = gridDim.x * gridDim.y * gridDim.z;
    unsigned sum, cnt, mine, sp = 0u;
    for (;;) {
        sum = 0u; cnt = 0u; mine = 0u;
#pragma unroll
        for (unsigned j = 0; j < 16; ++j) { const unsigned c = xb_ld(&bar[XB_XCNT(j)]); sum += c; cnt += (c > 0u) ? 1u : 0u; mine = (j == x) ? c : mine; }
        if (sum == G) break;
        __builtin_amdgcn_s_sleep(1);
        if ((++sp & 255u) == 0u) { if (xb_ld(&bar[XB_TMO])) break; if (sp > XB_SPIN_CAP) { atomicAdd(&bar[XB_TMO], 1u); break; } }
    }
    nloc = mine > 0u ? mine : 1u; nx = cnt > 0u ? cnt : 1u;
}

__device__ __forceinline__ void xcd_barrier(const XcdBarrier& b) {
    asm volatile("s_waitcnt vmcnt(0)" ::: "memory");
    __syncthreads();
    if (threadIdx.x == 0) {
        unsigned* bar = b.bar;
        __builtin_amdgcn_s_waitcnt(0);
        unsigned nloc = b.st[0], nx = b.st[1];
        if (nloc == 0u) { xcd_barrier_complete(bar, b.x, nloc, nx); b.st[0] = nloc; b.st[1] = nx; }
        const unsigned old = xb_add(&bar[XB_XSUB(b.x)], 1u);
        const unsigned gen = old / nloc;
        if (old + 1u == (gen + 1u) * nloc) {
            __builtin_amdgcn_fence(__ATOMIC_RELEASE, "agent");
            asm volatile("s_waitcnt vmcnt(0)" ::: "memory");
            const unsigned og = xb_add(&bar[XB_TOP], 1u);
            const unsigned tg = og / nx;
            if (og + 1u == (tg + 1u) * nx) xb_add(&bar[XB_TOPGEN], 1u);
            else XB_SPIN(xb_ld(&bar[XB_TOPGEN]) == tg, bar);
            __builtin_amdgcn_fence(__ATOMIC_ACQUIRE, "agent");
            xb_add(&bar[XB_XGEN(b.x)], 1u);
            asm volatile("s_waitcnt vmcnt(0)" ::: "memory");
        } else {
            XB_SPIN(xb_ld(&bar[XB_XGEN(b.x)]) == gen, bar);
            __builtin_amdgcn_fence(__ATOMIC_ACQUIRE, "agent");
            asm volatile("s_waitcnt vmcnt(0)" ::: "memory");
        }
    }
    __syncthreads();
}

constexpr size_t WS_BAR = WS_SIDE + 960 * 1024;

#define GSYNC() do { XcdBarrier b_; b_.bar = (unsigned*)(kargs()->ws + WS_BAR); b_.x = xb_xcc_id(); b_.st = (volatile LAS unsigned*)(lds + 147440); xcd_barrier(b_); } while (0)
__global__ void __launch_bounds__(NWAVES * 64, 2) fwd_mega(Args a) {
    extern __shared__ __attribute__((aligned(16))) unsigned char lds_raw[];
    LAS unsigned char* lds = (LAS unsigned char*)lds_raw;
    const int G = gridDim.x;
    unsigned char* ws = kargs()->ws;
    volatile LAS unsigned* xst = (volatile LAS unsigned*)(lds + 147440);
    if (threadIdx.x < 4) xst[threadIdx.x] = 0u;
    __syncthreads();
    { cg::grid_group grid = cg::this_grid(); if (kargs()->ws == nullptr) grid.sync(); }
    (void)xcd_barrier_post((unsigned*)(ws + WS_BAR), xst);
    bf16_t* XB = (bf16_t*)(ws + WS_XB); bf16_t* PB = (bf16_t*)(ws + WS_PB);
    bf16_t* T0 = (bf16_t*)(ws + WS_T);
    bf16_t* W_IN = (bf16_t*)(ws + WS_WIN); bf16_t* W_OUT = (bf16_t*)(ws + WS_WOUT); bf16_t* W_1 = (bf16_t*)(ws + WS_W1); bf16_t* W_2 = (bf16_t*)(ws + WS_W2);
    bf16_t* W_UP = (bf16_t*)(ws + WS_WUP); bf16_t* W_GATE = (bf16_t*)(ws + WS_WGATE);
    float* SSO = (float*)(ws + WS_SSO);
    const size_t E64 = (size_t)32 * MiB;

    prologue_rows(G);
    convert_in(0, lds, G);
    GSYNC();

    int sv = 0;
#ifdef PROBE_T
    LAS unsigned long long* TA = (LAS unsigned long long*)(lds + 146432);
    if (threadIdx.x == 0) { for (int q = 0; q < 8; ++q) TA[q] = 0ull; }
#define TSTAMP() __builtin_amdgcn_s_memrealtime()
#define TADD(c, t0) do { if (threadIdx.x == 0) TA[c] += TSTAMP() - (t0); } while (0)
#else
#define TSTAMP() 0ull
#define TADD(c, t0) do { (void)(t0); } while (0)
#endif
    for (int i = 0; i < 4; ++i) {
        const bool attn = (i & 1) == 0; const int j = i >> 1;
        for (int slot = 0; slot < 11; ++slot) {
            int sk = -1;
            int kind = 0;
            bool sync = false, flip = false;
            const bf16_t* gA = nullptr; const bf16_t* gB = nullptr; int gM = 0, gN = 0, gK = 0;
            EpiG E; E.mode = 0; E.layer = i; E.sv = sv; E.xbalt = 0; E.ret = 0; E.x0src = 0; E.nobf = 0; E.pad2_ = 0; E.ws = ws;
            if (slot == 0) { kind = 4; }
            else if (slot == 1) { kind = 1; sk = SK_PROJ; gA = XB; gB = W_IN; gM = M; gK = D;
                if (attn) { gN = 2048; E.mode = MODE_ATTN_QK; } else { gN = 4096; E.mode = MODE_RET_QKG; } }
            else if (slot == 2) { kind = 1; sync = true; gB = XB; gN = M; gK = D; E.mode = MODE_VT;
                if (attn) { gA = W_IN + (size_t)2048 * D; gM = 1024; } else { gA = W_IN + (size_t)4096 * D; gM = 2048; E.ret = 1; } }
            else if (slot == 3) { kind = 2; sync = true; }
            else if (slot == 4) { if (!attn) { kind = 3; sync = true; } }
            else if (slot == 5) { kind = 1; sk = SK_OUT; sync = true; flip = true; gB = W_OUT; gM = M; gN = D; E.mode = MODE_RESID; E.x0src = (i == 0);
                if (attn) { gA = T0 + 3 * E64; gK = 1024; } else { gA = T0 + 4 * E64; gK = 2048; } }
            else if (slot == 6) { kind = 1; sk = SK_W1; gA = XB; gB = W_1; gM = M; gN = FF; gK = D; E.mode = MODE_SQRELU; }
            else if (slot == 7) { kind = 1; sync = true; gA = PB; gB = W_UP; gM = M; gN = D; gK = PLE; E.mode = MODE_PLAIN; }
            else if (slot == 8) { kind = 1; sk = SK_W2; sync = true; flip = true; gA = T0; gB = W_2; gM = M; gN = D; gK = FF; E.mode = MODE_RESID; E.xbalt = 1; }
            else if (slot == 9) { if (i < 3) kind = 5; }
            else { kind = 1; sk = SK_GATE; sync = (i < 3); flip = true; gA = T0 + 5 * E64; gB = W_GATE; gM = M; gN = D; gK = D; E.mode = MODE_GATE; E.nobf = (i == 3); }

            const unsigned long long ts0 = TSTAMP();
            if (kind == 1) {
                __syncthreads();
                if (sk >= 0) { side_step(sk, i, sv, lds, G); if (sk == SK_PROJ) side_step(SK_UP, i, sv, lds, G, 128); TADD(5, ts0); }
                __syncthreads();
                pg8::Gemm g{gA, gB, gM, gN, gK}; pg8::StaticOrder S; S.init(gM, gN, G, opaque_bid());
#ifndef NO_GEMM
                pg8::gemm_phase<EpiG, pg8::StaticOrder, GEMM_ALIGN, GEMM_SP2>(lds, g, S, E);
#endif
            } else if (kind == 2) {
                __syncthreads();
                if (attn) {
                    const int lane = opaque_tid() & 63;
                    KArgs ka = kargs();
                    float d1 = ka->a_lq1[j * 64 + lane] * ka->a_lk1[j * 64 + lane], d2 = ka->a_lq2[j * 64 + lane] * ka->a_lk2[j * 64 + lane];
#pragma unroll
                    for (int o = 1; o < 64; o <<= 1) { d1 += __shfl_xor(d1, o); d2 += __shfl_xor(d2, o); }
                    const float lam = expf(d1) - expf(d2) + lambda_init_of(i);
                    side_mixer(i, lam, G);
#if defined(NAIVE_ATTN)
                    attn_naive(T0, T0 + E64, T0 + 2 * E64, T0 + 3 * E64, lam, G);
#elif !defined(NO_ATTN)
#ifdef ATTN_V1
                    attn_phase(lds, T0, T0 + E64, T0 + 2 * E64, T0 + 3 * E64, lam, G);
#else
                    attn_phase2(lds, T0, T0 + E64, T0 + 2 * E64, T0 + 3 * E64, lam, G);
#endif
#endif
                } else {
                    side_mixer(i, 0.f, G);
#if defined(NAIVE_RET)
                    ret_naive(T0, T0 + E64, T0 + 2 * E64, T0 + 4 * E64, SSO, G);
#elif !defined(NO_RET)
                    ret_phase(lds, T0, T0 + E64, T0 + 2 * E64, T0 + 4 * E64, SSO, G);
#endif
                }
            } else if (kind == 3) {
                ret_norm_phase(T0 + 4 * E64, SSO, G);
            } else if (kind == 4) {
                __syncthreads();
                convert_rest(i, lds, G);
            } else if (kind == 5) {
                __syncthreads();
                convert_in(i + 1, lds, G);
            }
            if (flip) sv ^= 1;
            const unsigned long long ts1 = TSTAMP();
            if (sync) { GSYNC(); TADD(3, ts1); }
            TADD((kind == 2 ? (attn ? 1 : 2) : kind == 3 ? 2 : (kind == 4 || kind == 5) ? 4 : 0), ts0);
        }
    }
#ifdef PROBE_T
    if (blockIdx.x == 0 && threadIdx.x == 0) kargs()->out[0] = (float)TA[PROBE_T] * 10.f;
#endif
}

extern "C" void kernel_launch(void* const* d_in, const int* in_sizes, int n_in, void* d_out, int out_size, void* d_ws, size_t ws_size, hipStream_t stream) {
    static int grid = 0;
    if (grid == 0) {
        if (n_in != 21 || out_size != M * D || ws_size < WS_END) { fprintf(stderr, "kernel_launch: unexpected shapes (n_in %d, out %d, ws %zu)\n", n_in, out_size, ws_size); grid = -1; return; }
        int dev = 0, cus = 0, per_cu = 0;
        hipGetDevice(&dev); hipDeviceGetAttribute(&cus, hipDeviceAttributeMultiprocessorCount, dev);
        hipFuncSetAttribute((const void*)fwd_mega, hipFuncAttributeMaxDynamicSharedMemorySize, LDS_BYTES);
        hipOccupancyMaxActiveBlocksPerMultiprocessor(&per_cu, (const void*)fwd_mega, NWAVES * 64, LDS_BYTES);
        if (per_cu < 1) per_cu = 1;
        grid = cus * per_cu;
        if (grid > 256) grid = 256;
        (void)hipGetLastError();
    }
    if (grid < 0) return;
    Args a{};
    a.x = (const float*)d_in[0]; a.p = (const float*)d_in[1]; a.norm_mix = (const float*)d_in[2]; a.norm_mlp = (const float*)d_in[3]; a.norm_pe = (const float*)d_in[4];
    a.a_w_qkv = (const float*)d_in[5]; a.a_w_o = (const float*)d_in[6]; a.a_g_q = (const float*)d_in[7]; a.a_g_k = (const float*)d_in[8];
    a.a_lq1 = (const float*)d_in[9]; a.a_lk1 = (const float*)d_in[10]; a.a_lq2 = (const float*)d_in[11]; a.a_lk2 = (const float*)d_in[12]; a.a_g_sub = (const float*)d_in[13];
    a.r_w_in = (const float*)d_in[14]; a.r_w_out = (const float*)d_in[15]; a.r_g_gn = (const float*)d_in[16]; a.mlp_w1 = (const float*)d_in[17]; a.mlp_w2 = (const float*)d_in[18];
    a.pe_w_up = (const float*)d_in[19]; a.pe_w_gate = (const float*)d_in[20];
    a.out = (float*)d_out; a.ws = (unsigned char*)d_ws;
    (void)hipMemsetAsync((unsigned char*)d_ws + WS_BAR, 0, XCD_BAR_WORDS * sizeof(unsigned), stream);
    void* args[] = {&a};
    hipError_t e = hipLaunchCooperativeKernel((const void*)fwd_mega, dim3(grid), dim3(NWAVES * 64), args, LDS_BYTES, stream);
    if (e != hipSuccess) fprintf(stderr, "cooperative launch failed: %s (grid %d)\n", hipGetErrorString(e), grid);
}
```
